# Optimizing an MI355X kernel written in HIP

```python
import math
import jax, jax.numpy as jnp
from jax import lax
import numpy as np

D_MODEL = 2048
BATCH = 8
SEQ = 2048
DEPTH = 4

N_MIXERS = 3
N_A = (DEPTH + 2) // 3
N_B = (DEPTH + 1) // 3
N_C = DEPTH // 3

MIX_WIDTH = 3 * D_MODEL // 4
MEM_LEN = 256
MEM_HEADS = 4
MEM_HEAD_DIM = D_MODEL // 16
MEM_WIDTH = MEM_HEADS * MEM_HEAD_DIM
OUT_WIDTH = MIX_WIDTH + MEM_WIDTH
NORM_EPS = 1e-6

SWA_HEAD_DIM = 64
SWA_Q_HEADS = MIX_WIDTH // SWA_HEAD_DIM
SWA_KV_HEADS = 4
SWA_GROUP = SWA_Q_HEADS // SWA_KV_HEADS
SWA_WINDOW = 128
SWA_BLOCK = 128
A_WIDTHS = (SWA_Q_HEADS * SWA_HEAD_DIM, SWA_KV_HEADS * SWA_HEAD_DIM, SWA_KV_HEADS * SWA_HEAD_DIM, MEM_WIDTH)

RWKV_HEAD_DIM = 64
RWKV_HEADS = MIX_WIDTH // RWKV_HEAD_DIM
RWKV_DECAY_RANK = 96
RWKV_ICLR_RANK = 96
RWKV_GATE_RANK = 256
RWKV_GN_EPS = 64e-5
B_SHIFT_WIDTHS = (MIX_WIDTH, MIX_WIDTH, MIX_WIDTH, RWKV_DECAY_RANK, RWKV_ICLR_RANK, RWKV_GATE_RANK)
B_SHIFT = sum(B_SHIFT_WIDTHS)

GDN_HEAD_DIM = 128
GDN_V_HEADS = MIX_WIDTH // GDN_HEAD_DIM
GDN_QK_HEADS = GDN_V_HEADS // 2
GDN_CONV = 4
GDN_CHUNK = 64
GDN_QK_WIDTH = GDN_QK_HEADS * GDN_HEAD_DIM
GDN_CONV_WIDTH = 2 * GDN_QK_WIDTH + MIX_WIDTH
C_WIDTHS = (GDN_QK_WIDTH, GDN_QK_WIDTH, MIX_WIDTH, MIX_WIDTH, GDN_V_HEADS, GDN_V_HEADS, MEM_WIDTH)

D_FF = 5632
FFN_CONV = 3

kernel_name = "hybrid_swa_rwkv7_gdn_memxattn_convffn"


def split_cols(p, widths):
    return jnp.split(p, [int(i) for i in np.cumsum(widths)[:-1]], axis=-1)


def rmsnorm(x, g):
    xf = x.astype(jnp.float32)
    y = xf * lax.rsqrt(jnp.mean(xf * xf, axis=-1, keepdims=True) + NORM_EPS)
    return (y * g.astype(jnp.float32)).astype(x.dtype)


def l2norm(x):
    x = x.astype(jnp.float32)
    return x * lax.rsqrt(jnp.sum(x * x, axis=-1, keepdims=True) + 1e-6)


def token_shift(x):
    return jnp.pad(x, ((0, 0), (1, 0), (0, 0)))[:, :-1]


def causal_dwconv(x, w):
    k_w, s = w.shape[0], x.shape[1]
    xp = jnp.pad(x, ((0, 0), (k_w - 1, 0), (0, 0)))
    out = xp[:, :s] * w[0]
    for j in range(1, k_w):
        out = out + xp[:, j:j + s] * w[j]
    return out


def alibi_slopes(n):
    return jnp.exp2(-8.0 * (jnp.arange(n, dtype=jnp.float32) + 1.0) / n)


def swa_sink_attention(q, k, v, sinks):
    b, s, _ = q.shape
    t, nb, dh = SWA_BLOCK, s // SWA_BLOCK, SWA_HEAD_DIM
    qb = q.reshape(b, nb, t, SWA_KV_HEADS, SWA_GROUP, dh)

    def banded(z):
        zb = z.reshape(b, nb, t, SWA_KV_HEADS, dh)
        prev = jnp.pad(zb, ((0, 0), (1, 0), (0, 0), (0, 0), (0, 0)))[:, :-1]
        return jnp.concatenate([prev, zb], axis=2)

    kb, vb = banded(k), banded(v)
    scores = jnp.einsum('bntkgd,bnjkd->bnkgtj', qb, kb).astype(jnp.float32) * (dh ** -0.5)
    blk = jnp.arange(nb)[:, None]
    qpos = blk * t + jnp.arange(t)[None, :]
    kpos = (blk - 1) * t + jnp.arange(2 * t)[None, :]
    dist = qpos[:, :, None] - kpos[:, None, :]
    valid = (dist >= 0) & (dist < SWA_WINDOW) & (kpos[:, None, :] >= 0)
    slopes = alibi_slopes(SWA_Q_HEADS).reshape(SWA_KV_HEADS, SWA_GROUP)
    bias = -slopes[None, :, :, None, None] * dist[:, None, None].astype(jnp.float32)
    scores = jnp.where(valid[:, None, None], scores + bias, -jnp.inf)
    sink = jnp.broadcast_to(sinks.astype(jnp.float32).reshape(1, 1, SWA_KV_HEADS, SWA_GROUP, 1, 1),
                            scores.shape[:-1] + (1,))
    probs = jax.nn.softmax(jnp.concatenate([scores, sink], axis=-1), axis=-1)[..., :-1]
    out = jnp.einsum('bnkgtj,bnjkd->bntkgd', probs.astype(v.dtype), vb)
    return out.reshape(b, s, SWA_Q_HEADS * dh)


def memory_attention(q, mem_kv):
    b, s, _ = q.shape
    qh = q.reshape(b, s, MEM_HEADS, MEM_HEAD_DIM)
    k, v = jnp.split(mem_kv, 2, axis=-1)
    kh = k.reshape(b, -1, MEM_HEADS, MEM_HEAD_DIM)
    vh = v.reshape(b, -1, MEM_HEADS, MEM_HEAD_DIM)
    scores = jnp.einsum('bshd,bmhd->bhsm', qh, kh).astype(jnp.float32) * (MEM_HEAD_DIM ** -0.5)
    probs = jax.nn.softmax(scores, axis=-1).astype(vh.dtype)
    return jnp.einsum('bhsm,bmhd->bshd', probs, vh).reshape(b, s, MEM_WIDTH)


def rwkv7_scan(r, w, k, v, kk, a):
    b, s, h, n = r.shape

    def step(state, inp):
        r_t, w_t, k_t, v_t, kk_t, a_t = inp
        sa = jnp.einsum('bhvk,bhk->bhv', state, -kk_t)
        state = (state * w_t[:, :, None, :] + sa[..., None] * (kk_t * a_t)[:, :, None, :]
                 + v_t[..., None] * k_t[:, :, None, :])
        return state, jnp.einsum('bhvk,bhk->bhv', state, r_t)

    xs = tuple(jnp.moveaxis(z, 1, 0) for z in (r, w, k, v, kk, a))
    _, ys = lax.scan(step, jnp.zeros((b, h, n, n), jnp.float32), xs)
    return jnp.moveaxis(ys, 0, 1)


def rwkv7_time_mix(p, mu, w0, w_decay_up, a0, w_iclr_up, w_gate_up, k_k, k_a, r_k, gn_g, gn_b):
    b, s, _ = p.shape
    f32 = jnp.float32
    h, n = RWKV_HEADS, RWKV_HEAD_DIM
    p = p + (token_shift(p) - p) * mu
    r, k, v, wd, ad, gd = split_cols(p, B_SHIFT_WIDTHS)
    w_log = -jax.nn.softplus(-(w0 + jnp.tanh(wd) @ w_decay_up).astype(f32)) - 0.5
    decay = jnp.exp(-jnp.exp(w_log))
    a = jax.nn.sigmoid((a0 + ad @ w_iclr_up).astype(f32))
    g = (jax.nn.sigmoid(gd) @ w_gate_up).astype(f32)
    k = k.astype(f32)
    heads = lambda z: z.reshape(b, s, h, n)
    kk = l2norm(heads(k * k_k))
    k = k * (1.0 + (a - 1.0) * k_a)
    rh, kh, vh = heads(r.astype(f32)), heads(k), heads(v.astype(f32))
    y = rwkv7_scan(rh, heads(decay), kh, vh, kk, heads(a))
    mean = jnp.mean(y, axis=-1, keepdims=True)
    var = jnp.mean(jnp.square(y - mean), axis=-1, keepdims=True)
    y = ((y - mean) * lax.rsqrt(var + RWKV_GN_EPS)).reshape(b, s, MIX_WIDTH) * gn_g + gn_b
    bonus = jnp.sum(rh * kh * r_k, axis=-1, keepdims=True) * vh
    y = y + bonus.reshape(b, s, MIX_WIDTH)
    return (y * g).astype(p.dtype)


def chunk_gated_delta_rule(q, k, v, g, beta):
    b, s, h, dk = q.shape
    dv = v.shape[-1]
    c = GDN_CHUNK
    nc = s // c
    chunks = lambda z: jnp.moveaxis(z.reshape(b, nc, c, h, -1), 3, 1)
    q = chunks(q * (dk ** -0.5))
    k = chunks(k)
    v = chunks(v)
    beta = chunks(beta[..., None])
    gc = jnp.cumsum(chunks(g[..., None])[..., 0], axis=-1)
    idx = jnp.arange(c)
    causal = idx[:, None] >= idx[None, :]
    strict = idx[:, None] > idx[None, :]
    decay = jnp.exp(jnp.where(causal, gc[..., :, None] - gc[..., None, :], -jnp.inf))
    kb = k * beta
    lmat = jnp.where(strict, jnp.einsum('bhnid,bhnjd->bhnij', kb, k) * decay, 0.0)
    eye = jnp.eye(c, dtype=lmat.dtype)
    tmat = lax.linalg.triangular_solve(lmat + eye, jnp.broadcast_to(eye, lmat.shape),
                                       left_side=True, lower=True, unit_diagonal=True)
    u = tmat @ (v * beta)
    w = tmat @ (kb * jnp.exp(gc)[..., None])
    a_qk = jnp.where(causal, jnp.einsum('bhnid,bhnjd->bhnij', q, k) * decay, 0.0)
    q_dec = q * jnp.exp(gc)[..., None]
    g_last = gc[..., -1]
    k_dec = k * jnp.exp(g_last[..., None] - gc)[..., None]

    def step(state, inp):
        u_c, w_c, qd_c, a_c, kd_c, gl_c = inp
        v_new = u_c - w_c @ state
        out = qd_c @ state + a_c @ v_new
        state = state * jnp.exp(gl_c)[..., None, None] + jnp.swapaxes(kd_c, -1, -2) @ v_new
        return state, out

    xs = tuple(jnp.moveaxis(z, 2, 0) for z in (u, w, q_dec, a_qk, k_dec, g_last))
    _, out = lax.scan(step, jnp.zeros((b, h, dk, dv), jnp.float32), xs)
    return jnp.transpose(out, (1, 0, 3, 2, 4)).reshape(b, s, h, dv)


def gated_deltanet(p, conv_w, a_log, dt_bias, norm_g):
    b, s, _ = p.shape
    f32 = jnp.float32
    qkv, z, bt, at = split_cols(p, (GDN_CONV_WIDTH, MIX_WIDTH, GDN_V_HEADS, GDN_V_HEADS))
    qkv = jax.nn.silu(causal_dwconv(qkv, conv_w))
    q, k, v = split_cols(qkv, (GDN_QK_WIDTH, GDN_QK_WIDTH, MIX_WIDTH))
    rep = GDN_V_HEADS // GDN_QK_HEADS
    q = jnp.repeat(l2norm(q.reshape(b, s, GDN_QK_HEADS, GDN_HEAD_DIM)), rep, axis=2)
    k = jnp.repeat(l2norm(k.reshape(b, s, GDN_QK_HEADS, GDN_HEAD_DIM)), rep, axis=2)
    v = v.reshape(b, s, GDN_V_HEADS, GDN_HEAD_DIM).astype(f32)
    beta = jax.nn.sigmoid(bt.astype(f32))
    g = -jnp.exp(a_log.astype(f32)) * jax.nn.softplus(at.astype(f32) + dt_bias.astype(f32))
    o = chunk_gated_delta_rule(q, k, v, g, beta)
    o = o * lax.rsqrt(jnp.mean(o * o, axis=-1, keepdims=True) + NORM_EPS) * norm_g.astype(f32)
    o = o.reshape(b, s, MIX_WIDTH) * jax.nn.silu(z.astype(f32))
    return o.astype(p.dtype)


def setup_inputs(seed: int = 0) -> dict:
    key = jax.random.key(seed)
    ks = iter(jax.random.split(key, 48))
    nrm = lambda shape, scale: jax.random.normal(next(ks), shape, jnp.float32) * scale
    gain = lambda shape: 1.0 + nrm(shape, 0.02)
    unif = lambda shape, lo, hi: jax.random.uniform(next(ks), shape, jnp.float32, lo, hi)
    d = D_MODEL
    a_in, b_in, c_in = sum(A_WIDTHS), B_SHIFT + MEM_WIDTH, sum(C_WIDTHS)
    dt = jnp.exp(unif((N_C, GDN_V_HEADS), math.log(1e-3), math.log(1e-1)))
    return {
        "x": nrm((BATCH, SEQ, d), 1.0),
        "mem": nrm((BATCH, MEM_LEN, d), 1.0),
        "attn_norm": gain((DEPTH, d)),
        "mem_norm": gain((DEPTH, d)),
        "w_mem_kv": nrm((DEPTH, d, 2 * MEM_WIDTH), d ** -0.5),
        "w_out": nrm((DEPTH, OUT_WIDTH, d), OUT_WIDTH ** -0.5),
        "ffn_norm": gain((DEPTH, d)),
        "w_ffn_up": nrm((DEPTH, d, 2 * D_FF), d ** -0.5),
        "ffn_conv": nrm((DEPTH, FFN_CONV, 2 * D_FF), FFN_CONV ** -0.5),
        "w_ffn_down": nrm((DEPTH, D_FF, d), D_FF ** -0.5),
        "final_norm": gain((d,)),
        "a_w_in": nrm((N_A, d, a_in), d ** -0.5),
        "a_sinks": nrm((N_A, SWA_Q_HEADS), 0.5),
        "b_w_in": nrm((N_B, d, b_in), d ** -0.5),
        "b_mu": unif((N_B, B_SHIFT), 0.0, 1.0),
        "b_w0": unif((N_B, MIX_WIDTH), -6.0, -1.0),
        "b_w_decay_up": nrm((N_B, RWKV_DECAY_RANK, MIX_WIDTH), 0.1 * RWKV_DECAY_RANK ** -0.5),
        "b_a0": nrm((N_B, MIX_WIDTH), 0.1),
        "b_w_iclr_up": nrm((N_B, RWKV_ICLR_RANK, MIX_WIDTH), RWKV_ICLR_RANK ** -0.5),
        "b_w_gate_up": nrm((N_B, RWKV_GATE_RANK, MIX_WIDTH), RWKV_GATE_RANK ** -0.5),
        "b_k_k": 0.85 + nrm((N_B, MIX_WIDTH), 0.02),
        "b_k_a": gain((N_B, MIX_WIDTH)),
        "b_r_k": nrm((N_B, RWKV_HEADS, RWKV_HEAD_DIM), 0.1),
        "b_gn_g": gain((N_B, MIX_WIDTH)),
        "b_gn_b": nrm((N_B, MIX_WIDTH), 0.02),
        "c_w_in": nrm((N_C, d, c_in), d ** -0.5),
        "c_conv": nrm((N_C, GDN_CONV, GDN_CONV_WIDTH), GDN_CONV ** -0.5),
        "c_a_log": jnp.log(unif((N_C, GDN_V_HEADS), 1.0, 16.0)),
        "c_dt_bias": dt + jnp.log(-jnp.expm1(-dt)),
        "c_norm_g": gain((N_C, GDN_HEAD_DIM)),
    }


def reference(x, mem, attn_norm, mem_norm, w_mem_kv, w_out, ffn_norm, w_ffn_up, ffn_conv, w_ffn_down,
              final_norm, a_w_in, a_sinks, b_w_in, b_mu, b_w0, b_w_decay_up, b_a0, b_w_iclr_up,
              b_w_gate_up, b_k_k, b_k_a, b_r_k, b_gn_g, b_gn_b, c_w_in, c_conv, c_a_log, c_dt_bias,
              c_norm_g):
    for i in range(DEPTH):
        kind, j = i % N_MIXERS, i // N_MIXERS
        h = rmsnorm(x, attn_norm[i])
        mem_kv = rmsnorm(mem, mem_norm[i]) @ w_mem_kv[i]
        if kind == 0:
            q, k, v, q_mem = split_cols(h @ a_w_in[j], A_WIDTHS)
            y = swa_sink_attention(q, k, v, a_sinks[j])
        elif kind == 1:
            p = h @ b_w_in[j]
            p_mix, q_mem = p[..., :B_SHIFT], p[..., B_SHIFT:]
            y = rwkv7_time_mix(p_mix, b_mu[j], b_w0[j], b_w_decay_up[j], b_a0[j], b_w_iclr_up[j],
                               b_w_gate_up[j], b_k_k[j], b_k_a[j], b_r_k[j], b_gn_g[j], b_gn_b[j])
        else:
            p = h @ c_w_in[j]
            p_mix, q_mem = p[..., :-MEM_WIDTH], p[..., -MEM_WIDTH:]
            y = gated_deltanet(p_mix, c_conv[j], c_a_log[j], c_dt_bias[j], c_norm_g[j])
        y_mem = memory_attention(q_mem, mem_kv)
        x = x + jnp.concatenate([y, y_mem], axis=-1) @ w_out[i]
        hf = rmsnorm(x, ffn_norm[i])
        u = causal_dwconv(hf @ w_ffn_up[i], ffn_conv[i])
        u_gate, u_val = jnp.split(u, 2, axis=-1)
        x = x + (jax.nn.silu(u_gate) * u_val) @ w_ffn_down[i]
    return rmsnorm(x, final_norm)
```

```cpp
#include <hip/hip_runtime.h>
#include <hip/hip_cooperative_groups.h>
#include <cstdio>
#include <cstdint>
namespace cg = cooperative_groups;
namespace pg8 {
#define PG8_LAS __attribute__((address_space(3)))
typedef unsigned short bf16_t;
typedef short bf16x8 __attribute__((ext_vector_type(8)));
typedef float f32x4 __attribute__((ext_vector_type(4)));
typedef unsigned u32x4 __attribute__((ext_vector_type(4)));
constexpr int BM = 256, BK = 64, HALF = 128, HTB = HALF * BK * 2  , STAGE_BYTES = 8 * HTB, NXCD = 8, WGM = 4;

__host__ __device__ __forceinline__ int lds_byte(int r, int c) { const int st = (r >> 4) * 2 + (c >> 5), rr = r & 15, cc = c & 31, ob = rr * 64 + cc * 2; return st * 1024 + (ob ^ (((ob >> 9) & 1) << 5)); }
__host__ __device__ __forceinline__ void stage_rc(int b, int& R, int& C) { const int st = b / 1024, sb = b % 1024, swz = sb ^ (((sb >> 9) & 1) << 5); R = (st >> 1) * 16 + swz / 64; C = (st & 1) * 32 + (swz % 64) / 2; }
__host__ __device__ __forceinline__ int perm32(int rho) { const int n = rho >> 4, i = rho & 15; return 8 * (i >> 2) + 4 * n + (i & 3); }

struct Unit { int pm, pn; };
struct Gemm { const bf16_t* A; const bf16_t* Bt; int M, N, K; };

struct StaticOrder {
    int nM, nN, nwg, G, c;
    __host__ __device__ void init(int M, int N, int G_, int c_) { nM = M / BM; nN = N / BM; nwg = nM * nN; G = G_; c = c_; }
    __host__ __device__ bool next(int i, Unit& u) const {
        const long L = (long)i * G + c; if (L >= nwg) return false;
        int wgid = (int)L; { const int q = nwg / NXCD, r = nwg % NXCD, xcd = wgid % NXCD, off = wgid / NXCD; wgid = (xcd < r ? xcd * (q + 1) : r * (q + 1) + (xcd - r) * q) + off; }
        const int nig = WGM * nN, gid = wgid / nig, fm = gid * WGM, gsz = (nM - fm) < WGM ? (nM - fm) : WGM;
        u.pm = fm + ((wgid % nig) % gsz); u.pn = (wgid % nig) / gsz; return true;
    }
    __device__ __forceinline__ void a_ready(const Unit&) const {}
    __device__ __forceinline__ void done(const Unit&) const {}
};

__device__ __forceinline__ unsigned cvt_pk_bf16(float lo, float hi) { unsigned r; asm volatile("v_cvt_pk_bf16_f32 %0, %1, %2" : "=v"(r) : "v"(lo), "v"(hi)); return r; }
typedef unsigned u32x2v __attribute__((ext_vector_type(2)));
__device__ __forceinline__ float rs_from_partials(const float* SSP, int row, int fq) {
    const f32x4 a = *(const f32x4*)(SSP + (size_t)row * 32 + 8 * fq), b = *(const f32x4*)(SSP + (size_t)row * 32 + 8 * fq + 4);
    float s = ((a[0] + a[1]) + (a[2] + a[3])) + ((b[0] + b[1]) + (b[2] + b[3]));
    s += __shfl_xor(s, 16); s += __shfl_xor(s, 32);
    return __builtin_amdgcn_rsqf(s * (1.f / 2048.f) + 1e-6f);
}
struct EpiF32 {
    static constexpr bool PERM = false, AFTER_DRAIN = false;
    float* O; int ldc; const float* SS;
    __device__ __forceinline__ void operator()(const f32x4 (&acc)[2][2][4][2], const Unit& u, int wr, int wc, int fr, int fq) const {
#pragma unroll
        for (int ai = 0; ai < 2; ++ai)
#pragma unroll
            for (int m = 0; m < 4; ++m) { const int row = u.pm * BM + ai * HALF + wr * 64 + m * 16 + fr; float* rowp = O + (size_t)row * ldc + u.pn * BM + wc * 32 + 4 * fq;
                const float rs = SS ? rs_from_partials(SS, row, fq) : 1.f;
#pragma unroll
                for (int bj = 0; bj < 2; ++bj)
#pragma unroll
                    for (int n = 0; n < 2; ++n) *(f32x4*)(rowp + bj * HALF + n * 16) = acc[ai][bj][m][n] * rs; }
    }
};
struct EpiRes {
    static constexpr bool PERM = false, AFTER_DRAIN = false;
    const float* base; float* out; int ldc;
    __device__ __forceinline__ void operator()(const f32x4 (&acc)[2][2][4][2], const Unit& u, int wr, int wc, int fr, int fq) const {
#pragma unroll
        for (int ai = 0; ai < 2; ++ai)
#pragma unroll
            for (int m = 0; m < 4; ++m) { const size_t off = (size_t)(u.pm * BM + ai * HALF + wr * 64 + m * 16 + fr) * ldc + u.pn * BM + wc * 32 + 4 * fq;
#pragma unroll
                for (int bj = 0; bj < 2; ++bj)
#pragma unroll
                    for (int n = 0; n < 2; ++n) { const f32x4 b = *(const f32x4*)(base + off + bj * HALF + n * 16); *(f32x4*)(out + off + bj * HALF + n * 16) = b + acc[ai][bj][m][n]; }
                asm volatile("" ::: "memory"); }
    }
};
struct EpiB16 {
    static constexpr bool PERM = true, AFTER_DRAIN = false;
    bf16_t* O; int ldc; const float* SS;
    __device__ __forceinline__ void operator()(const f32x4 (&acc)[2][2][4][2], const Unit& u, int wr, int wc, int fr, int fq) const {
        const int row0 = u.pm * BM + wr * 64 + fr, col0 = u.pn * BM + wc * 32 + 8 * fq;
#pragma unroll
        for (int ai = 0; ai < 2; ++ai)
#pragma unroll
            for (int m = 0; m < 4; ++m) { const int row = row0 + ai * HALF + m * 16; bf16_t* rowp = O + (size_t)row * ldc + col0;
                const float rs = rs_from_partials(SS, row, fq);
#pragma unroll
                for (int bj = 0; bj < 2; ++bj) { const f32x4 v0 = acc[ai][bj][m][0] * rs, v1 = acc[ai][bj][m][1] * rs;
                    u32x4 w; w.x = cvt_pk_bf16(v0[0], v0[1]); w.y = cvt_pk_bf16(v0[2], v0[3]); w.z = cvt_pk_bf16(v1[0], v1[1]); w.w = cvt_pk_bf16(v1[2], v1[3]);
                    *(u32x4*)(rowp + bj * HALF) = w; } }
    }
};
struct EpiResNorm {
    static constexpr bool PERM = true, AFTER_DRAIN = false;
    const float* base; float* out; int ldc; const float* g; bf16_t* XG; float* SS;
    __device__ __forceinline__ void operator()(const f32x4 (&acc)[2][2][4][2], const Unit& u, int wr, int wc, int fr, int fq) const {
        const int row0 = u.pm * BM + wr * 64 + fr, col0 = u.pn * BM + wc * 32 + 8 * fq;
        f32x4 gv[2][2];
#pragma unroll
        for (int bj = 0; bj < 2; ++bj)
#pragma unroll
            for (int n = 0; n < 2; ++n) gv[bj][n] = *(const f32x4*)(g + col0 + bj * HALF + 4 * n);
#pragma unroll
        for (int ai = 0; ai < 2; ++ai) {
            f32x4 rb[4][2][2];
#pragma unroll
            for (int m = 0; m < 4; ++m) { const size_t off = (size_t)(row0 + ai * HALF + m * 16) * ldc + col0;
#pragma unroll
                for (int bj = 0; bj < 2; ++bj) { rb[m][bj][0] = *(const f32x4*)(base + off + bj * HALF); rb[m][bj][1] = *(const f32x4*)(base + off + bj * HALF + 4); } }
#pragma unroll
            for (int m = 0; m < 4; ++m) { const int row = row0 + ai * HALF + m * 16; const size_t off = (size_t)row * ldc + col0; float ss = 0.f;
#pragma unroll
                for (int bj = 0; bj < 2; ++bj) {
                    const f32x4 x0 = rb[m][bj][0] + acc[ai][bj][m][0], x1 = rb[m][bj][1] + acc[ai][bj][m][1];
                    if (out) { *(f32x4*)(out + off + bj * HALF) = x0; *(f32x4*)(out + off + bj * HALF + 4) = x1; }
                    ss += (x0[0] * x0[0] + x0[1] * x0[1]) + (x0[2] * x0[2] + x0[3] * x0[3]) + (x1[0] * x1[0] + x1[1] * x1[1]) + (x1[2] * x1[2] + x1[3] * x1[3]);
                    const f32x4 y0 = x0 * gv[bj][0], y1 = x1 * gv[bj][1];
                    u32x4 w; w.x = cvt_pk_bf16(y0[0], y0[1]); w.y = cvt_pk_bf16(y0[2], y0[3]); w.z = cvt_pk_bf16(y1[0], y1[1]); w.w = cvt_pk_bf16(y1[2], y1[3]);
                    *(u32x4*)(XG + off + bj * HALF) = w; }
                ss += __shfl_xor(ss, 16); ss += __shfl_xor(ss, 32);
                if (fq == 0) SS[(size_t)row * 32 + u.pn * 4 + wc] = ss; }
            asm volatile("" ::: "memory");
        }
    }
};
struct EpiUpConv {
    static constexpr bool PERM = true, AFTER_DRAIN = false;
    bf16_t* ACT; const float* SS; const float* cw; float* RAWB; PG8_LAS unsigned char* xch;
    static __device__ __forceinline__ float dpp_shr1(float old, float src) { return __builtin_bit_cast(float, __builtin_amdgcn_update_dpp(__builtin_bit_cast(int, old), __builtin_bit_cast(int, src), 0x111, 0xf, 0xf, false)); }
    static __device__ __forceinline__ float dpp_shr2(float old, float src) { return __builtin_bit_cast(float, __builtin_amdgcn_update_dpp(__builtin_bit_cast(int, old), __builtin_bit_cast(int, src), 0x112, 0xf, 0xf, false)); }
    static __device__ __forceinline__ float dpp_ror1(float src) { return __builtin_bit_cast(float, __builtin_amdgcn_update_dpp(0, __builtin_bit_cast(int, src), 0x121, 0xf, 0xf, true)); }
    static __device__ __forceinline__ float dpp_ror2(float src) { return __builtin_bit_cast(float, __builtin_amdgcn_update_dpp(0, __builtin_bit_cast(int, src), 0x122, 0xf, 0xf, true)); }
    __device__ __forceinline__ void operator()(const f32x4 (&acc)[2][2][4][2], const Unit& u, int wr, int wc, int fr, int fq) const {
        const int row0 = u.pm * BM + wr * 64 + fr, cidx = wc * 32 + 8 * fq;
        float rs[2][4];
#pragma unroll
        for (int ai = 0; ai < 2; ++ai)
#pragma unroll
            for (int m = 0; m < 4; ++m) rs[ai][m] = rs_from_partials(SS, row0 + ai * HALF + m * 16, fq);
#pragma unroll
        for (int ai = 0; ai < 2; ++ai) {
            const int gi = ai * 2 + wr;
            if (fr >= 14) {
                const int r = fr - 14;
#pragma unroll
                for (int bj = 0; bj < 2; ++bj)
#pragma unroll
                    for (int n = 0; n < 2; ++n) { const f32x4 v = acc[ai][bj][3][n] * rs[ai][3];
                        *(PG8_LAS f32x4*)(xch + ((((gi * 2 + r) * 2 + bj) * 128) + cidx + 4 * n) * 4) = v;
                        if (gi == 3) *(f32x4*)(RAWB + ((size_t)u.pm * 4 + 2 + r) * 11264 + bj * 5632 + u.pn * 128 + cidx + 4 * n) = v; }
            }
            if (gi == 0 && fr < 2) {
#pragma unroll
                for (int bj = 0; bj < 2; ++bj)
#pragma unroll
                    for (int n = 0; n < 2; ++n) *(f32x4*)(RAWB + ((size_t)u.pm * 4 + fr) * 11264 + bj * 5632 + u.pn * 128 + cidx + 4 * n) = acc[ai][bj][0][n] * rs[ai][0];
            }
        }
        asm volatile("s_waitcnt lgkmcnt(0)" ::: "memory"); __builtin_amdgcn_s_barrier(); asm volatile("" ::: "memory");
#pragma unroll
        for (int n = 0; n < 2; ++n) {
            f32x4 w[2][3];
#pragma unroll
            for (int bj = 0; bj < 2; ++bj)
#pragma unroll
                for (int j = 0; j < 3; ++j) w[bj][j] = *(const f32x4*)(cw + j * 11264 + bj * 5632 + u.pn * 128 + cidx + 4 * n);
#pragma unroll
            for (int ai = 0; ai < 2; ++ai) {
                const int gi = ai * 2 + wr;
                f32x4 o1[2], o2[2];
#pragma unroll
                for (int bj = 0; bj < 2; ++bj) {
                    o1[bj] = (f32x4){0.f, 0.f, 0.f, 0.f}; o2[bj] = o1[bj];
                    if (gi > 0) { o1[bj] = *(const PG8_LAS f32x4*)(xch + (((((gi - 1) * 2 + 1) * 2 + bj) * 128) + cidx + 4 * n) * 4);
                                  o2[bj] = *(const PG8_LAS f32x4*)(xch + (((((gi - 1) * 2 + (fr == 0 ? 0 : 1)) * 2 + bj) * 128) + cidx + 4 * n) * 4); }
                }
#pragma unroll
                for (int m = 0; m < 4; ++m) {
                    f32x4 uu[2];
#pragma unroll
                    for (int bj = 0; bj < 2; ++bj) { const f32x4 cur = acc[ai][bj][m][n] * rs[ai][m];
#pragma unroll
                        for (int q = 0; q < 4; ++q) { const float p1 = dpp_shr1(o1[bj][q], cur[q]), p2 = dpp_shr2(o2[bj][q], cur[q]);
                            uu[bj][q] = w[bj][0][q] * p2 + w[bj][1][q] * p1 + w[bj][2][q] * cur[q];
                            o1[bj][q] = dpp_ror1(cur[q]); o2[bj][q] = dpp_ror2(cur[q]); } }
                    u32x2v o;
                    { const float a0 = uu[0][0] * __builtin_amdgcn_rcpf(1.f + __expf(-uu[0][0])) * uu[1][0], a1 = uu[0][1] * __builtin_amdgcn_rcpf(1.f + __expf(-uu[0][1])) * uu[1][1];
                      const float a2 = uu[0][2] * __builtin_amdgcn_rcpf(1.f + __expf(-uu[0][2])) * uu[1][2], a3 = uu[0][3] * __builtin_amdgcn_rcpf(1.f + __expf(-uu[0][3])) * uu[1][3];
                      o.x = cvt_pk_bf16(a0, a1); o.y = cvt_pk_bf16(a2, a3); }
                    *(u32x2v*)(ACT + (size_t)(row0 + ai * HALF + m * 16) * 5632 + u.pn * 128 + cidx + 4 * n) = o;
                }
            }
        }
    }
};
template <class Epi, class Sched, bool ALIGN_EPI = false, bool SP2 = false>
__device__ __forceinline__ void gemm_phase(PG8_LAS unsigned char* lds, const Gemm g, const Sched& S, const Epi& E) {
    int tid_ = threadIdx.x; asm volatile("" : "+v"(tid_));
    const int tid = tid_, wid = __builtin_amdgcn_readfirstlane(tid >> 6), lane = tid & 63, wr = wid >> 2, wc = wid & 3, fr = lane & 15, fq = lane >> 4;
    const int K = g.K, nt = K / BK;
    unsigned voffA[2], voffB[2];
#pragma unroll
    for (int i = 0; i < 2; ++i) { int R, C; stage_rc(tid * 16 + i * 8192, R, C); const int Rb = Epi::PERM ? ((R & ~31) + perm32(R & 31)) : R;
        voffA[i] = (unsigned)(R * K + C) * 2u; voffB[i] = (unsigned)(Rb * K + C) * 2u; }
    const size_t kstep = (size_t)(BK * 2);
    const size_t hstep = (size_t)HALF * K * 2;
    const size_t tstep = 2 * hstep;
    const unsigned ldsw = (unsigned)wid * 1024u;
    const int aoff = lds_byte(wr * 64 + fr, fq * 8), boff = lds_byte(wc * 32 + fr, fq * 8);
#define PG8_SA(b, h) (((b) * 2 + (h)) * HTB)
#define PG8_SB(b, h) ((4 + (b) * 2 + (h)) * HTB)
#define PG8_STAGE(bufoff, gbase, voff) do { _Pragma("unroll") for (int _i = 0; _i < 2; ++_i) \
        __builtin_amdgcn_global_load_lds((const unsigned*)((const char*)(gbase) + (voff)[_i]), (PG8_LAS unsigned*)(lds + (bufoff) + ldsw + _i * 8192), 16, 0, 0); } while (0)
#define PG8_LDA(dst, b, h) do { _Pragma("unroll") for (int m = 0; m < 4; ++m) _Pragma("unroll") for (int k = 0; k < 2; ++k) dst[m][k] = *(const PG8_LAS bf16x8*)(lds + PG8_SA(b, h) + aoff + m * 2048 + k * 1024); } while (0)
#define PG8_LDB(dst, b, h) do { _Pragma("unroll") for (int n = 0; n < 2; ++n) _Pragma("unroll") for (int k = 0; k < 2; ++k) dst[n][k] = *(const PG8_LAS bf16x8*)(lds + PG8_SB(b, h) + boff + n * 2048 + k * 1024); } while (0)
#define PG8_MMA(ai, bj, At, Bt) do { __builtin_amdgcn_s_setprio(1); _Pragma("unroll") for (int m = 0; m < 4; ++m) _Pragma("unroll") for (int n = 0; n < 2; ++n) _Pragma("unroll") for (int k = 0; k < 2; ++k) \
        acc[ai][bj][m][n] = __builtin_amdgcn_mfma_f32_16x16x32_bf16(Bt[n][k], At[m][k], acc[ai][bj][m][n], 0, 0, 0); __builtin_amdgcn_s_setprio(0); } while (0)
#define PG8_WAIT_V(n) asm volatile("s_waitcnt vmcnt(" #n ")" ::: "memory")
#define PG8_WAIT_L(n) asm volatile("s_waitcnt lgkmcnt(" #n ")" ::: "memory")
#define PG8_BAR __builtin_amdgcn_s_barrier()
#define PG8_SCHED __builtin_amdgcn_sched_barrier(0)
    Unit cur, nxt; int ui = 0;
    if (!S.next(0, cur)) return;
    f32x4 acc[2][2][4][2];
#pragma unroll
    for (int a = 0; a < 2; ++a)
#pragma unroll
        for (int b = 0; b < 2; ++b)
#pragma unroll
            for (int m = 0; m < 4; ++m)
#pragma unroll
                for (int n = 0; n < 2; ++n) acc[a][b][m][n] = (f32x4){0.f, 0.f, 0.f, 0.f};
    bf16x8 At[4][2], B0[2][2], B1[2][2];
    const char* cA = (const char*)g.A + (size_t)cur.pm * tstep; const char* cB = (const char*)g.Bt + (size_t)cur.pn * tstep;
    S.a_ready(cur);
    if constexpr (SP2) {
        PG8_STAGE(PG8_SB(0, 0), cB, voffB); PG8_STAGE(PG8_SB(0, 1), cB + hstep, voffB); PG8_STAGE(PG8_SA(0, 0), cA, voffA); PG8_STAGE(PG8_SA(0, 1), cA + hstep, voffA);
        if (wr == 1) PG8_BAR;
        PG8_WAIT_V(2); PG8_BAR;
        PG8_STAGE(PG8_SB(1, 0), cB + kstep, voffB); PG8_STAGE(PG8_SA(1, 0), cA + kstep, voffA); PG8_STAGE(PG8_SB(1, 1), cB + hstep + kstep, voffB);
        PG8_WAIT_V(6); PG8_BAR;
    } else {
        PG8_STAGE(PG8_SB(0, 0), cB, voffB); PG8_STAGE(PG8_SA(0, 0), cA, voffA); PG8_STAGE(PG8_SB(0, 1), cB + hstep, voffB); PG8_STAGE(PG8_SA(0, 1), cA + hstep, voffA);
        if (wr == 1) PG8_BAR;
        PG8_WAIT_V(4); PG8_BAR;
        PG8_STAGE(PG8_SB(1, 0), cB + kstep, voffB); PG8_STAGE(PG8_SA(1, 0), cA + kstep, voffA); PG8_STAGE(PG8_SB(1, 1), cB + hstep + kstep, voffB);
        PG8_WAIT_V(6); PG8_BAR;
    }
    for (;;) {
        const bool has_next = S.next(ui + 1, nxt);
        const char* nA = has_next ? (const char*)g.A + (size_t)nxt.pm * tstep : cA; const char* nB = has_next ? (const char*)g.Bt + (size_t)nxt.pn * tstep : cB;
        for (int t = 0; t < nt; t += 2) {
            const bool last = (t == nt - 2);
            const char* a1 = cA + (size_t)(t + 1) * kstep;
            const char* a2 = last ? nA : cA + (size_t)(t + 2) * kstep; const char* b2 = last ? nB : cB + (size_t)(t + 2) * kstep;
            const char* a3 = a2 + kstep; const char* b3 = b2 + kstep;
            if (last && has_next) S.a_ready(nxt);
            if constexpr (SP2) {
            PG8_LDB(B0, 0, 0); PG8_LDB(B1, 0, 1); PG8_SCHED; PG8_LDA(At, 0, 0); PG8_STAGE(PG8_SA(1, 1), a1 + hstep, voffA);
            PG8_WAIT_V(8); PG8_WAIT_L(0); PG8_BAR; PG8_MMA(0, 0, At, B0); PG8_MMA(0, 1, At, B1); PG8_BAR; PG8_SCHED;
            PG8_LDA(At, 0, 1); PG8_STAGE(PG8_SB(0, 0), b2, voffB); PG8_STAGE(PG8_SB(0, 1), b2 + hstep, voffB); PG8_STAGE(PG8_SA(0, 0), a2, voffA);
            PG8_WAIT_V(8); PG8_WAIT_L(0); PG8_BAR; PG8_MMA(1, 0, At, B0); PG8_MMA(1, 1, At, B1); PG8_BAR; PG8_SCHED;
            PG8_LDB(B0, 1, 0); PG8_LDB(B1, 1, 1); PG8_SCHED; PG8_LDA(At, 1, 0); PG8_STAGE(PG8_SA(0, 1), a2 + hstep, voffA);
            PG8_WAIT_V(8); PG8_WAIT_L(0); PG8_BAR; PG8_MMA(0, 0, At, B0); PG8_MMA(0, 1, At, B1); PG8_BAR; PG8_SCHED;
            PG8_LDA(At, 1, 1); PG8_STAGE(PG8_SB(1, 0), b3, voffB); PG8_STAGE(PG8_SB(1, 1), b3 + hstep, voffB); PG8_STAGE(PG8_SA(1, 0), a3, voffA);
            PG8_WAIT_V(8); PG8_WAIT_L(0); PG8_BAR; PG8_MMA(1, 0, At, B0); PG8_MMA(1, 1, At, B1); PG8_BAR; PG8_SCHED;
            } else {
            PG8_LDB(B0, 0, 0); PG8_SCHED; PG8_LDA(At, 0, 0); PG8_STAGE(PG8_SA(1, 1), a1 + hstep, voffA);
            PG8_WAIT_L(8); PG8_BAR; PG8_WAIT_L(0); PG8_MMA(0, 0, At, B0); PG8_BAR; PG8_SCHED;
            PG8_LDB(B1, 0, 1); PG8_STAGE(PG8_SB(0, 0), b2, voffB);
            PG8_BAR; PG8_WAIT_L(0); PG8_MMA(0, 1, At, B1); PG8_BAR;
            PG8_LDA(At, 0, 1); PG8_STAGE(PG8_SA(0, 0), a2, voffA);
            PG8_BAR; PG8_WAIT_L(0); PG8_MMA(1, 0, At, B0); PG8_BAR; PG8_SCHED;
            PG8_STAGE(PG8_SB(0, 1), b2 + hstep, voffB);
            PG8_WAIT_V(6); PG8_BAR; PG8_MMA(1, 1, At, B1); PG8_BAR;
            PG8_LDB(B0, 1, 0); PG8_SCHED; PG8_LDA(At, 1, 0); PG8_STAGE(PG8_SA(0, 1), a2 + hstep, voffA);
            PG8_WAIT_L(8); PG8_BAR; PG8_WAIT_L(0); PG8_MMA(0, 0, At, B0); PG8_BAR; PG8_SCHED;
            PG8_LDB(B1, 1, 1); PG8_STAGE(PG8_SB(1, 0), b3, voffB);
            PG8_BAR; PG8_WAIT_L(0); PG8_MMA(0, 1, At, B1); PG8_BAR;
            PG8_LDA(At, 1, 1); PG8_STAGE(PG8_SA(1, 0), a3, voffA);
            PG8_BAR; PG8_WAIT_L(0); PG8_MMA(1, 0, At, B0); PG8_BAR; PG8_SCHED;
            PG8_STAGE(PG8_SB(1, 1), b3 + hstep, voffB);
            PG8_WAIT_V(6); PG8_BAR; PG8_MMA(1, 1, At, B1); PG8_BAR;
            }
        }
        if constexpr (ALIGN_EPI) { if (wr == 0) PG8_BAR; }
        if constexpr (!Epi::AFTER_DRAIN) { E(acc, cur, wr, wc, fr, fq); S.done(cur); }
        if (!has_next) break;
#pragma unroll
        for (int a = 0; a < 2; ++a)
#pragma unroll
            for (int b = 0; b < 2; ++b)
#pragma unroll
                for (int m = 0; m < 4; ++m)
#pragma unroll
                    for (int n = 0; n < 2; ++n) acc[a][b][m][n] = (f32x4){0.f, 0.f, 0.f, 0.f};
        cur = nxt; cA = nA; cB = nB; ++ui;
        if constexpr (ALIGN_EPI) { if (wr == 1) PG8_BAR; }
    }
    PG8_WAIT_V(0);
    if constexpr (!ALIGN_EPI) { if (wr == 0) PG8_BAR; }
    PG8_BAR;
    if constexpr (Epi::AFTER_DRAIN) { E.fused(acc, cur, wr, wc, fr, fq, lds, wid, lane); S.done(cur); }
#undef PG8_SA
#undef PG8_SB
#undef PG8_STAGE
#undef PG8_LDA
#undef PG8_LDB
#undef PG8_MMA
#undef PG8_WAIT_V
#undef PG8_WAIT_L
#undef PG8_BAR
#undef PG8_SCHED
}
}

#define DI __device__ __forceinline__
#define LAS __attribute__((address_space(3)))
typedef unsigned short bf16;
typedef float f32x2 __attribute__((ext_vector_type(2)));
typedef float f32x4 __attribute__((ext_vector_type(4)));
typedef float f32x16 __attribute__((ext_vector_type(16)));
typedef short bf16x8 __attribute__((ext_vector_type(8)));
typedef short s16x4 __attribute__((ext_vector_type(4)));
typedef unsigned u32x2 __attribute__((ext_vector_type(2)));
typedef unsigned u32x4 __attribute__((ext_vector_type(4)));
typedef __bf16 bf16x2_t __attribute__((ext_vector_type(2)));

constexpr int NBATCH = 8, SEQ = 2048, T = NBATCH * SEQ, DM = 2048, MIXW = 1536, MEMW = 512, MEML = 256, DFF = 5632;
constexpr int NPH = 32;
constexpr float LOG2E = 1.4426950408889634f;
constexpr int LDS_BYTES = 147456;

constexpr size_t MiB = 1u << 20;
constexpr size_t WS_WIN = 1 * MiB;
constexpr size_t WS_WMKV = 23 * MiB;
constexpr size_t WS_WOUT = 27 * MiB;
constexpr size_t WS_WUP = 35 * MiB;
constexpr size_t WS_WDOWN = 79 * MiB;
constexpr size_t WS_WLORA = 101 * MiB;
constexpr size_t WS_X = 106 * MiB;
constexpr size_t WS_H = 234 * MiB;
constexpr size_t WS_YCAT = 298 * MiB;
constexpr size_t WS_MEMN = 362 * MiB;
constexpr size_t WS_MEMKV = 370 * MiB;
constexpr size_t WS_LORAIN = 378 * MiB;
constexpr size_t WS_P = 394 * MiB;
constexpr size_t WS_LO = 746 * MiB;
constexpr size_t WS_SSPA = 1034 * MiB;
constexpr size_t WS_SSPF = 1036 * MiB;
constexpr size_t WS_WSET1 = 1038 * MiB;
constexpr size_t WS_RAWB = 1144 * MiB;
constexpr size_t WS_MEMN4 = 1156 * MiB;
constexpr size_t WS_END = 1188 * MiB;

DI unsigned pk2(float lo, float hi) { f32x2 v = {lo, hi}; bf16x2_t b = __builtin_convertvector(v, bf16x2_t); return __builtin_bit_cast(unsigned, b); }
DI float bflo(unsigned w) { return __uint_as_float(w << 16); }
DI float bfhi(unsigned w) { return __uint_as_float(w & 0xffff0000u); }
#define LDS_WAIT() asm volatile("s_waitcnt lgkmcnt(0)" ::: "memory")
template <int CTRL> DI float dppf(float x) { return __builtin_bit_cast(float, __builtin_amdgcn_mov_dpp(__builtin_bit_cast(int, x), CTRL, 0xf, 0xf, true)); }
DI float red16(float v) { v += dppf<0xB1>(v); v += dppf<0x4E>(v); v += dppf<0x141>(v); v += dppf<0x128>(v); return v; }
DI float wave_sum(float v) {
#pragma unroll
    for (int o = 1; o < 64; o <<= 1) v += __shfl_xor(v, o);
    return v;
}
DI float dot4(f32x4 a, f32x4 b) { return (a.x * b.x + a.y * b.y) + (a.z * b.z + a.w * b.w); }
DI float frcp(float x) { return __builtin_amdgcn_rcpf(x); }
DI float frsq(float x) { return __builtin_amdgcn_rsqf(x); }
DI float sigmoidf_(float x) { return frcp(1.f + __expf(-x)); }
DI float softplusf_(float x) { return fmaxf(x, 0.f) + __logf(1.f + __expf(-fabsf(x))); }
DI float siluf_(float x) { return x * frcp(1.f + __expf(-x)); }
DI float tanhf_(float x) { return 1.f - 2.f * frcp(__expf(2.f * x) + 1.f); }
DI int crow(int reg, int h) { return (reg & 3) + 8 * (reg >> 2) + 4 * h; }
DI void lds_barrier() { asm volatile("s_waitcnt lgkmcnt(0)" ::: "memory"); __builtin_amdgcn_s_barrier(); asm volatile("" ::: "memory"); }
#define MFMA32(a, b, c) __builtin_amdgcn_mfma_f32_32x32x16_bf16((a), (b), (c), 0, 0, 0)

DI int up_rowmap(int n) { const int hv = n >= 5632 ? 1 : 0, nn = n - hv * 5632; return ((nn >> 7) << 8) + hv * 128 + (nn & 127); }
DI void transpose_item(const float* W, int K, int N, bf16* WT, int item, int nblk, LAS float* scr, int lane, bool up_perm) {
    const int kb = item / nblk, nb = item - kb * nblk, k0 = 64 * kb, n0 = 64 * nb;
    const int c4 = (lane & 15) * 4, kr = lane >> 4;
    const bool inb = (n0 + c4) < N;
    const float* src = W + (size_t)(k0 + kr) * N + n0 + c4;
    f32x4 v[16];
#pragma unroll
    for (int i = 0; i < 16; ++i) v[i] = inb ? *(const f32x4*)(src + (size_t)(4 * i) * N) : (f32x4){0.f, 0.f, 0.f, 0.f};
#pragma unroll
    for (int i = 0; i < 16; ++i) { LAS float* d = scr + (4 * i + kr) * 65 + c4; d[0] = v[i].x; d[1] = v[i].y; d[2] = v[i].z; d[3] = v[i].w; }
    LDS_WAIT(); asm volatile("" ::: "memory");
    const int kc = lane & 7;
#pragma unroll
    for (int j = 0; j < 8; ++j) { const int n = (lane >> 3) + 8 * j; const LAS float* s = scr + (8 * kc) * 65 + n;
        u32x4 o; o.x = pk2(s[0 * 65], s[1 * 65]); o.y = pk2(s[2 * 65], s[3 * 65]); o.z = pk2(s[4 * 65], s[5 * 65]); o.w = pk2(s[6 * 65], s[7 * 65]);
        const int orow = up_perm ? up_rowmap(n0 + n) : n0 + n;
        *(u32x4*)(WT + (size_t)orow * K + k0 + 8 * kc) = o; }
    LDS_WAIT(); asm volatile("" ::: "memory");
}
DI void transpose_weight(const float* W, int K, int N, int Npad, bf16* WT, LAS float* scr, int gw, int NGW, int lane, bool up_perm = false) {
    const int nblk = Npad / 64, nitems = (K / 64) * nblk;
    for (int it = gw; it < nitems; it += NGW) transpose_item(W, K, N, WT, it, nblk, scr, lane, up_perm);
}
DI float lora_w(const float* wd, const float* wa, const float* wg, int n, int k) {
    if (n < 1536) return (k < 96) ? wd[k * 1536 + n] : 0.f;
    if (n < 3072) return (k >= 96 && k < 192) ? wa[(k - 96) * 1536 + (n - 1536)] : 0.f;
    return (k >= 192 && k < 448) ? wg[(k - 192) * 1536 + (n - 3072)] : 0.f;
}

DI void rms_row_bf16(const float* xrow, const float* g, bf16* orow, int lane) {
    const f32x4* xr = (const f32x4*)xrow + lane;
    f32x4 v[8]; float s = 0.f;
#pragma unroll
    for (int j = 0; j < 8; ++j) { v[j] = xr[64 * j]; s += dot4(v[j], v[j]); }
    const float rs = frsq(wave_sum(s) * (1.f / 2048.f) + 1e-6f);
    const f32x4* gr = (const f32x4*)g + lane;
    u32x2* o8 = (u32x2*)orow + lane;
#pragma unroll
    for (int j = 0; j < 8; ++j) { const f32x4 gv = gr[64 * j]; const f32x4 o = v[j] * rs * gv; u32x2 w; w.x = pk2(o.x, o.y); w.y = pk2(o.z, o.w); o8[64 * j] = w; }
}
DI void xg_row(const float* xrow, const float* g, bf16* orow, float* ss_out, int lane) {
    const f32x4* xr = (const f32x4*)xrow + lane;
    const f32x4* gr = (const f32x4*)g + lane;
    u32x2* o8 = (u32x2*)orow + lane;
    float s = 0.f;
#pragma unroll
    for (int j = 0; j < 8; ++j) { const f32x4 v = xr[64 * j]; s += dot4(v, v); const f32x4 o = v * gr[64 * j]; u32x2 w; w.x = pk2(o.x, o.y); w.y = pk2(o.z, o.w); o8[64 * j] = w; }
    s = wave_sum(s);
    if (lane < 32) ss_out[lane] = lane == 0 ? s : 0.f;
}
DI void rms_row_f32(const float* xrow, const float* g, float* orow, int lane) {
    const f32x4* xr = (const f32x4*)xrow + lane;
    f32x4 v[8]; float s = 0.f;
#pragma unroll
    for (int j = 0; j < 8; ++j) { v[j] = xr[64 * j]; s += dot4(v[j], v[j]); }
    const float rs = frsq(wave_sum(s) * (1.f / 2048.f) + 1e-6f);
    const f32x4* gr = (const f32x4*)g + lane;
    f32x4* o = (f32x4*)orow + lane;
#pragma unroll
    for (int j = 0; j < 8; ++j) o[64 * j] = v[j] * rs * gr[64 * j];
}

template <int D> DI void stage_kv(LAS unsigned char* lds, const float* kbase, const float* vbase, long stride, int koff, bool zero_first, int tid) {
    constexpr int KP = D + 8, VP = 264, C4 = D / 4, V_OFF = 256 * KP * 2;
    constexpr int NKT = 256 * C4 / 512, NVT = 128 * C4 / 512;
#pragma unroll 1
    for (int h0 = 0; h0 < NKT; h0 += 4) {
        f32x4 v[4];
#pragma unroll
        for (int i = 0; i < 4; ++i) { const int task = tid + 512 * (h0 + i), key = task / C4, d4 = task - key * C4;
            v[i] = (f32x4){0.f, 0.f, 0.f, 0.f};
            if (!(zero_first && key < 128)) v[i] = *(const f32x4*)(kbase + (long)(koff + key) * stride + 4 * d4); }
#pragma unroll
        for (int i = 0; i < 4; ++i) { const int task = tid + 512 * (h0 + i), key = task / C4, d4 = task - key * C4;
            u32x2 w; w.x = pk2(v[i].x, v[i].y); w.y = pk2(v[i].z, v[i].w);
            *(LAS u32x2*)(lds + (key * KP + 4 * d4) * 2) = w; }
        asm volatile("" ::: "memory");
    }
#pragma unroll 1
    for (int h0 = 0; h0 < NVT; h0 += 2) {
        f32x4 a[2], b[2];
#pragma unroll
        for (int i = 0; i < 2; ++i) { const int task = tid + 512 * (h0 + i), kp = task & 127, d4 = task >> 7;
            a[i] = (f32x4){0.f, 0.f, 0.f, 0.f}; b[i] = a[i];
            if (!(zero_first && kp < 64)) { a[i] = *(const f32x4*)(vbase + (long)(koff + 2 * kp) * stride + 4 * d4); b[i] = *(const f32x4*)(vbase + (long)(koff + 2 * kp + 1) * stride + 4 * d4); } }
#pragma unroll
        for (int i = 0; i < 2; ++i) { const int task = tid + 512 * (h0 + i), kp = task & 127, d4 = task >> 7;
#pragma unroll
            for (int q = 0; q < 4; ++q) *(LAS unsigned*)(lds + V_OFF + ((4 * d4 + q) * VP + 2 * kp) * 2) = pk2(a[i][q], b[i][q]); }
        asm volatile("" ::: "memory");
    }
}
template <int D, bool SWA> DI void attn_unit(LAS unsigned char* lds, const float* qrow, float scale2, float slope2, float sink2, int qpos, bool skip0, bf16* orow, int lane) {
    constexpr int KP = D + 8, VP = 264, NKS = D / 16, NDT = D / 32, V_OFF = 256 * KP * 2;
    const int r32 = lane & 31, h = lane >> 5;
    const int qs = __builtin_amdgcn_readfirstlane(qpos >> 5);
    bf16x8 qf[NKS];
#pragma unroll
    for (int ks = 0; ks < NKS; ++ks) { const f32x4 a = *(const f32x4*)(qrow + ks * 16 + 8 * h) * scale2, b = *(const f32x4*)(qrow + ks * 16 + 8 * h + 4) * scale2;
        u32x4 w; w.x = pk2(a.x, a.y); w.y = pk2(a.z, a.w); w.z = pk2(b.x, b.y); w.w = pk2(b.z, b.w); qf[ks] = __builtin_bit_cast(bf16x8, w); }
    float m = SWA ? sink2 : -1e30f, l = (SWA && h == 0) ? 1.f : 0.f;
    f32x16 O[NDT];
#pragma unroll
    for (int dt = 0; dt < NDT; ++dt)
#pragma unroll
        for (int i = 0; i < 16; ++i) O[dt][i] = 0.f;
#pragma unroll 1
    for (int c = 0; c < 2; ++c) {
        if (SWA && skip0 && c == 0) continue;
        f32x16 S[4];
        float mx = -1e30f;
#pragma unroll
        for (int kt = 0; kt < 4; ++kt) {
            const bool dead = SWA && (c == 0 ? kt < qs : kt > qs), part = SWA && kt == qs;
            if (!dead) {
#pragma unroll
                for (int i = 0; i < 16; ++i) S[kt][i] = 0.f;
#pragma unroll
                for (int ks = 0; ks < NKS; ++ks) { const bf16x8 kf = *(const LAS bf16x8*)(lds + ((c * 128 + kt * 32 + r32) * KP + ks * 16 + 8 * h) * 2); S[kt] = MFMA32(kf, qf[ks], S[kt]); }
#pragma unroll
                for (int i = 0; i < 16; ++i) {
                    if (SWA) { const int j = c * 128 + kt * 32 + crow(i, h); const int dist = qpos + 128 - j;
                        const float sb = S[kt][i] - slope2 * (float)dist;
                        S[kt][i] = (!part || ((dist >= 0) && (dist < 128))) ? sb : -1e30f; }
                    mx = fmaxf(mx, S[kt][i]);
                }
            }
        }
        mx = fmaxf(mx, __shfl_xor(mx, 32));
        const float mn = fmaxf(m, mx), alpha = __builtin_amdgcn_exp2f(m - mn);
        m = mn; l *= alpha;
#pragma unroll
        for (int dt = 0; dt < NDT; ++dt)
#pragma unroll
            for (int i = 0; i < 16; ++i) O[dt][i] *= alpha;
        float ps = 0.f;
#pragma unroll
        for (int kt = 0; kt < 4; ++kt) {
            const bool dead = SWA && (c == 0 ? kt < qs : kt > qs);
            if (!dead) {
#pragma unroll
                for (int i = 0; i < 16; ++i) { const float p = __builtin_amdgcn_exp2f(S[kt][i] - mn); S[kt][i] = p; ps += p; }
#pragma unroll
                for (int s = 0; s < 2; ++s) {
                    u32x4 w; w.x = pk2(S[kt][8 * s + 0], S[kt][8 * s + 1]); w.y = pk2(S[kt][8 * s + 2], S[kt][8 * s + 3]); w.z = pk2(S[kt][8 * s + 4], S[kt][8 * s + 5]); w.w = pk2(S[kt][8 * s + 6], S[kt][8 * s + 7]);
                    const bf16x8 pf = __builtin_bit_cast(bf16x8, w);
#pragma unroll
                    for (int dt = 0; dt < NDT; ++dt) {
                        const LAS unsigned char* ap = lds + V_OFF + ((dt * 32 + r32) * VP + c * 128 + kt * 32 + s * 16 + 4 * h) * 2;
                        const s16x4 lo = *(const LAS s16x4*)ap, hi = *(const LAS s16x4*)(ap + 16);
                        const bf16x8 vf = __builtin_shufflevector(lo, hi, 0, 1, 2, 3, 4, 5, 6, 7);
                        O[dt] = MFMA32(vf, pf, O[dt]);
                    }
                }
            }
        }
        l += ps;
    }
    const float lt = l + __shfl_xor(l, 32), inv = frcp(lt);
#pragma unroll
    for (int dt = 0; dt < NDT; ++dt)
#pragma unroll
        for (int g = 0; g < 4; ++g) { u32x2 w; w.x = pk2(O[dt][4 * g] * inv, O[dt][4 * g + 1] * inv); w.y = pk2(O[dt][4 * g + 2] * inv, O[dt][4 * g + 3] * inv);
            *(u32x2*)(orow + dt * 32 + 8 * g + 4 * h) = w; }
}
DI void swa_item(LAS unsigned char* lds, int it, const float* P, int ld, const float* sinks, bf16* YCAT, int tid, int lane, int wave) {
    const int b = it >> 6, rem = it & 63, blk = rem >> 2, kvh = rem & 3;
    const long tok0 = (long)b * SEQ + blk * 128;
    __syncthreads();
    stage_kv<64>(lds, P + tok0 * ld + 1536 + kvh * 64, P + tok0 * ld + 1792 + kvh * 64, ld, -128, blk == 0, tid);
    __syncthreads();
    for (int u = wave; u < 24; u += 8) {
        const int g = u >> 2, qs = u & 3, hq = kvh * 6 + g, qpos = qs * 32 + (lane & 31);
        const long tq = tok0 + qpos;
        const float slope = exp2f(-8.f * (float)(hq + 1) / 24.f);
        attn_unit<64, true>(lds, P + tq * ld + hq * 64, 0.125f * LOG2E, slope * LOG2E, sinks[hq] * LOG2E, qpos, blk == 0, YCAT + tq * DM + hq * 64, lane);
    }
}
DI void mem_item(LAS unsigned char* lds, int it, const float* P, int ld, int qoff, const float* MEMKV, bf16* YCAT, int tid, int lane, int wave) {
    const int b = it >> 5, rem = it & 31, hh = rem >> 3, qc = rem & 7;
    __syncthreads();
    stage_kv<128>(lds, MEMKV + (long)(b * MEML) * 1024 + hh * 128, MEMKV + (long)(b * MEML) * 1024 + 512 + hh * 128, 1024, 0, false, tid);
    __syncthreads();
    const long tq = (long)b * SEQ + qc * 256 + wave * 32 + (lane & 31);
    attn_unit<128, false>(lds, P + tq * ld + qoff + hh * 128, 0.08838834764831845f * LOG2E, 0.f, 0.f, 0, false, YCAT + tq * DM + MIXW + hh * 128, lane);
}

DI void rwkv_prep_row(const float* P, const float* mu, bf16* LIN, long tg, int lane) {
    u32x4 o = {0u, 0u, 0u, 0u};
    if (lane < 56) {
        const int col = 4608 + 8 * lane;
        const float* cur = P + tg * 5632 + col;
        f32x4 c0 = *(const f32x4*)cur, c1 = *(const f32x4*)(cur + 4), p0 = {0.f, 0.f, 0.f, 0.f}, p1 = {0.f, 0.f, 0.f, 0.f};
        if ((tg & (SEQ - 1)) != 0) { p0 = *(const f32x4*)(cur - 5632); p1 = *(const f32x4*)(cur - 5632 + 4); }
        const f32x4 m0 = *(const f32x4*)(mu + col), m1 = *(const f32x4*)(mu + col + 4);
        f32x4 x0 = c0 + (p0 - c0) * m0, x1 = c1 + (p1 - c1) * m1;
        if (lane < 12) {
#pragma unroll
            for (int i = 0; i < 4; ++i) { x0[i] = tanhf_(x0[i]); x1[i] = tanhf_(x1[i]); }
        } else if (lane >= 24) {
#pragma unroll
            for (int i = 0; i < 4; ++i) { x0[i] = sigmoidf_(x0[i]); x1[i] = sigmoidf_(x1[i]); }
        }
        o.x = pk2(x0.x, x0.y); o.y = pk2(x0.z, x0.w); o.z = pk2(x1.x, x1.y); o.w = pk2(x1.z, x1.w);
    }
    *(u32x4*)(LIN + tg * 512 + 8 * lane) = o;
}

struct RwkvPar { const float *mu, *w0, *a0, *k_k, *k_a, *r_k, *gn_g, *gn_b; };
DI void rwkv_scan_block(LAS unsigned char* lds, int c, const float* P, const float* LO, const RwkvPar& pr, bf16* YCAT, int tid, int lane, int wave) {
    const int b = c / 24, h = c - b * 24;
    const long tok_base = (long)b * SEQ;
    LAS float* R_ = (LAS float*)(lds + 0);
    LAS float* W_ = (LAS float*)(lds + 8192);
    LAS float* K_ = (LAS float*)(lds + 16384);
    LAS float* V_ = (LAS float*)(lds + 24576);
    LAS float* KK_ = (LAS float*)(lds + 32768);
    LAS float* KA_ = (LAS float*)(lds + 40960);
    LAS float* G_ = (LAS float*)(lds + 49152);
    LAS float* Y_ = (LAS float*)(lds + 57344);
    LAS float* BS_ = (LAS float*)(lds + 65536);
    LAS float* RAW = (LAS float*)(lds + 65792);
    const int dt = tid >> 4, k4 = (tid & 15) * 4, ch = h * 64 + k4;
    const int kq = lane & 15, rp = lane >> 4, row0 = wave * 8 + rp * 2;
    f32x4 S0 = {0.f, 0.f, 0.f, 0.f}, S1 = {0.f, 0.f, 0.f, 0.f};
    f32x4 pre[7];
#define RW_LOAD(cidx) do { const int t0_ = (cidx) * 32; _Pragma("unroll") for (int j = 0; j < 7; ++j) { const int e = tid + 512 * j; pre[j] = (f32x4){0.f, 0.f, 0.f, 0.f}; \
        if (e < 3168) { const int row = e / 96, rm = e - row * 96, s = rm >> 4, kk4 = rm & 15; const int t = t0_ - 1 + row; \
            if (t >= 0) { const long tg = tok_base + t; const float* src = (s < 3) ? P + tg * 5632 + s * 1536 + h * 64 + 4 * kk4 : LO + tg * 4608 + (s - 3) * 1536 + h * 64 + 4 * kk4; pre[j] = *(const f32x4*)src; } } } } while (0)
#define RW_WRITE() do { _Pragma("unroll") for (int j = 0; j < 7; ++j) { const int e = tid + 512 * j; if (e < 3168) *(LAS f32x4*)(RAW + 4 * e) = pre[j]; } } while (0)
#define RW_RAW(row, s) (*(const LAS f32x4*)(RAW + ((row) * 6 + (s)) * 64 + k4))
#define RW_DERIVE() do { \
        const f32x4 mu_r = *(const f32x4*)(pr.mu + ch), mu_k = *(const f32x4*)(pr.mu + 1536 + ch), mu_v = *(const f32x4*)(pr.mu + 3072 + ch); \
        const f32x4 cr = RW_RAW(dt + 1, 0), ck = RW_RAW(dt + 1, 1), cv = RW_RAW(dt + 1, 2); \
        const f32x4 xr = cr + (RW_RAW(dt, 0) - cr) * mu_r, xk = ck + (RW_RAW(dt, 1) - ck) * mu_k, xv = cv + (RW_RAW(dt, 2) - cv) * mu_v; \
        const f32x4 wl = *(const f32x4*)(pr.w0 + ch) + RW_RAW(dt + 1, 3), al = *(const f32x4*)(pr.a0 + ch) + RW_RAW(dt + 1, 4); \
        f32x4 dec, av; _Pragma("unroll") for (int i = 0; i < 4; ++i) { const float wlog = -softplusf_(-wl[i]) - 0.5f; dec[i] = __expf(-__expf(wlog)); av[i] = sigmoidf_(al[i]); } \
        const f32x4 kkn = xk * *(const f32x4*)(pr.k_k + ch); const float ss = red16(dot4(kkn, kkn)); const f32x4 kk = kkn * (frsq(ss + 1e-6f)); \
        const f32x4 kp = xk * (1.f + (av - 1.f) * *(const f32x4*)(pr.k_a + ch)); \
        const float bs = red16(dot4(xr * kp, *(const f32x4*)(pr.r_k + ch))); \
        *(LAS f32x4*)(R_ + dt * 64 + k4) = xr; *(LAS f32x4*)(W_ + dt * 64 + k4) = dec; *(LAS f32x4*)(K_ + dt * 64 + k4) = kp; *(LAS f32x4*)(V_ + dt * 64 + k4) = xv; \
        *(LAS f32x4*)(KK_ + dt * 64 + k4) = kk; *(LAS f32x4*)(KA_ + dt * 64 + k4) = kk * av; *(LAS f32x4*)(G_ + dt * 64 + k4) = RW_RAW(dt + 1, 5); \
        if ((tid & 15) == 0) BS_[dt] = bs; } while (0)
    RW_LOAD(0);
#pragma unroll 1
    for (int cidx = 0; cidx < 64; ++cidx) {
        RW_WRITE();
        lds_barrier();
        RW_DERIVE();
        lds_barrier();
        if (cidx + 1 < 64) RW_LOAD(cidx + 1);
        f32x4 nkk = *(const LAS f32x4*)(KK_ + 4 * kq), nw = *(const LAS f32x4*)(W_ + 4 * kq), nka = *(const LAS f32x4*)(KA_ + 4 * kq);
        f32x4 nk = *(const LAS f32x4*)(K_ + 4 * kq), nr = *(const LAS f32x4*)(R_ + 4 * kq);
        f32x2 nv = *(const LAS f32x2*)(V_ + row0);
#pragma unroll 2
        for (int t = 0; t < 32; ++t) {
            const f32x4 kk4 = nkk, w4 = nw, ka4 = nka, kv4 = nk, r4 = nr; const f32x2 v2 = nv;
            const int tn = (t + 1) * 64;
            nkk = *(const LAS f32x4*)(KK_ + tn + 4 * kq); nw = *(const LAS f32x4*)(W_ + tn + 4 * kq); nka = *(const LAS f32x4*)(KA_ + tn + 4 * kq);
            nk = *(const LAS f32x4*)(K_ + tn + 4 * kq); nr = *(const LAS f32x4*)(R_ + tn + 4 * kq); nv = *(const LAS f32x2*)(V_ + tn + row0);
            const float p0 = red16(dot4(S0, kk4)), p1 = red16(dot4(S1, kk4));
            S0 = S0 * w4 - p0 * ka4 + v2.x * kv4;
            S1 = S1 * w4 - p1 * ka4 + v2.y * kv4;
            const float y0 = red16(dot4(S0, r4)), y1 = red16(dot4(S1, r4));
            if (kq == 0) *(LAS f32x2*)(Y_ + t * 64 + row0) = (f32x2){y0, y1};
        }
        lds_barrier();
        {
            const f32x4 y4 = *(const LAS f32x4*)(Y_ + dt * 64 + k4);
            const float mean = red16((y4.x + y4.y) + (y4.z + y4.w)) * (1.f / 64.f);
            const f32x4 d = y4 - mean;
            const float var = red16(dot4(d, d)) * (1.f / 64.f);
            const f32x4 yn = d * (frsq(var + 64e-5f)) * *(const f32x4*)(pr.gn_g + ch) + *(const f32x4*)(pr.gn_b + ch);
            const f32x4 o = (yn + BS_[dt] * *(const LAS f32x4*)(V_ + dt * 64 + k4)) * *(const LAS f32x4*)(G_ + dt * 64 + k4);
            u32x2 w; w.x = pk2(o.x, o.y); w.y = pk2(o.z, o.w);
            *(u32x2*)(YCAT + (tok_base + cidx * 32 + dt) * DM + ch) = w;
        }
    }
#undef RW_LOAD
#undef RW_WRITE
#undef RW_RAW
#undef RW_DERIVE
}

DI f32x4 gd_conv4(const LAS float* CW, const LAS float* RAW, int dt, int cc) {
    f32x4 a = {0.f, 0.f, 0.f, 0.f};
#pragma unroll
    for (int j = 0; j < 4; ++j) a += *(const LAS f32x4*)(CW + j * 320 + cc) * *(const LAS f32x4*)(RAW + (dt + j) * 320 + cc);
#pragma unroll
    for (int i = 0; i < 4; ++i) a[i] = siluf_(a[i]);
    return a;
}
struct GdnPar { const float *conv, *a_log, *dt_bias; };
#define MFMA16F(a, b, c) __builtin_amdgcn_mfma_f32_16x16x4f32((a), (b), (c), 0, 0, 0)
DI void gdn_scan_block(LAS unsigned char* lds, int c, const float* P, const GdnPar& pr, float* ORAW, int tid, int lane, int wave) {
    constexpr int LD = 5376, KP = 132;
    const int b = c / 24, r24 = c - b * 24, vh = r24 >> 1, half = r24 & 1, qh = vh >> 1;
    const long tok_base = (long)b * SEQ;
    LAS float* Q_ = (LAS float*)(lds + 0);
    LAS float* K_ = (LAS float*)(lds + 16896);
    LAS float* V_ = (LAS float*)(lds + 33792);
    LAS float* AB_ = (LAS float*)(lds + 41984);
    LAS float* GC_ = (LAS float*)(lds + 42240);
    LAS float* E31_ = (LAS float*)(lds + 42368);
    LAS float* GM = (LAS float*)(lds + 42496);
    LAS float* HM = (LAS float*)(lds + 46720);
    LAS float* BM = (LAS float*)(lds + 50944);
    LAS float* M2 = (LAS float*)(lds + 55040);
    LAS float* RH = (LAS float*)(lds + 59264);
    LAS float* CC = (LAS float*)(lds + 67456);
    LAS float* CW = (LAS float*)(lds + 75648);
    LAS float* RAW = (LAS float*)(lds + 80768);
    LAS float* RAB = (LAS float*)(lds + 125568);
    LAS unsigned char* KB = lds + 125824;
    LAS unsigned char* QB = lds + 134528;
    const int dt = tid >> 4, seg = tid & 15;
    const int m = lane & 15, g = lane >> 4;
#define GD_COL(cc) ((cc) < 128 ? qh * 128 + (cc) : (cc) < 256 ? 768 + qh * 128 + ((cc) - 128) : 1536 + vh * 128 + half * 64 + ((cc) - 256))
    for (int e = tid; e < 4 * 320; e += 512) { const int j = e / 320, cc = e - j * 320; CW[e] = pr.conv[j * 3072 + GD_COL(cc)]; }
    const float neg_ea = -__expf(pr.a_log[vh]), dtb = pr.dt_bias[vh];
    f32x4 Sacc[8];
#pragma unroll
    for (int i = 0; i < 8; ++i) Sacc[i] = (f32x4){0.f, 0.f, 0.f, 0.f};
    f32x4 pre[6]; float pre_bt = 0.f, pre_at = 0.f;
#define GD_LOAD(cidx) do { const int t0_ = (cidx) * 32; _Pragma("unroll") for (int j = 0; j < 6; ++j) { const int e = tid + 512 * j; pre[j] = (f32x4){0.f, 0.f, 0.f, 0.f}; \
        if (e < 2800) { const int row = e / 80, c4 = e - row * 80; const int t = t0_ - 3 + row; \
            if (t >= 0) { const int cc = 4 * c4; pre[j] = *(const f32x4*)(P + (tok_base + t) * LD + GD_COL(cc)); } } } \
        if (tid < 32) { const float* pp = P + (tok_base + t0_ + tid) * LD; pre_bt = pp[4608 + vh]; pre_at = pp[4620 + vh]; } } while (0)
#define GD_WRITE() do { _Pragma("unroll") for (int j = 0; j < 6; ++j) { const int e = tid + 512 * j; if (e < 2800) *(LAS f32x4*)(RAW + 4 * e) = pre[j]; } \
        if (tid < 32) { RAB[2 * tid] = pre_bt; RAB[2 * tid + 1] = pre_at; } } while (0)
#define GD_CONV4(cc) gd_conv4(CW, RAW, dt, (cc))
#define GD_DERIVE() do { \
        f32x4 q0 = GD_CONV4(seg * 8), q1 = GD_CONV4(seg * 8 + 4), k0 = GD_CONV4(128 + seg * 8), k1 = GD_CONV4(128 + seg * 8 + 4); const f32x4 v0 = GD_CONV4(256 + seg * 4); \
        const float qs = 0.08838834764831845f * frsq(red16(dot4(q0, q0) + dot4(q1, q1)) + 1e-6f), ks = frsq(red16(dot4(k0, k0) + dot4(k1, k1)) + 1e-6f); \
        *(LAS f32x4*)(Q_ + dt * KP + seg * 8) = q0 * qs; *(LAS f32x4*)(Q_ + dt * KP + seg * 8 + 4) = q1 * qs; \
        *(LAS f32x4*)(K_ + dt * KP + seg * 8) = k0 * ks; *(LAS f32x4*)(K_ + dt * KP + seg * 8 + 4) = k1 * ks; \
        *(LAS f32x4*)(V_ + dt * 64 + seg * 4) = v0; \
        { const f32x4 a0_ = q0 * qs, a1_ = q1 * qs, b0_ = k0 * ks, b1_ = k1 * ks; u32x4 wq, wk; \
          wq.x = pk2(a0_.x, a0_.y); wq.y = pk2(a0_.z, a0_.w); wq.z = pk2(a1_.x, a1_.y); wq.w = pk2(a1_.z, a1_.w); \
          wk.x = pk2(b0_.x, b0_.y); wk.y = pk2(b0_.z, b0_.w); wk.z = pk2(b1_.x, b1_.y); wk.w = pk2(b1_.z, b1_.w); \
          *(LAS u32x4*)(QB + (dt * 136 + seg * 8) * 2) = wq; *(LAS u32x4*)(KB + (dt * 136 + seg * 8) * 2) = wk; } \
        if (seg == 0) { AB_[2 * dt] = neg_ea * softplusf_(RAB[2 * dt + 1] + dtb); AB_[2 * dt + 1] = sigmoidf_(RAB[2 * dt]); } } while (0)
    GD_LOAD(0);
#pragma unroll 1
    for (int cidx = 0; cidx < 64; ++cidx) {
        GD_WRITE();
        lds_barrier();
        GD_DERIVE();
        lds_barrier();
        if (cidx + 1 < 64) GD_LOAD(cidx + 1);
        f32x4 P0a[2], PQa[2];
        if (wave < 4) {
#pragma unroll
            for (int tb = 0; tb < 2; ++tb) { P0a[tb] = (f32x4){0.f, 0.f, 0.f, 0.f}; PQa[tb] = P0a[tb]; }
#pragma unroll
            for (int kb8 = 0; kb8 < 8; ++kb8)
#pragma unroll
                for (int i = 0; i < 4; ++i) { const float bS = Sacc[kb8][i];
#pragma unroll
                    for (int tb = 0; tb < 2; ++tb) { const int off = (16 * tb + m) * KP + 16 * kb8 + 4 * g + i;
                        P0a[tb] = MFMA16F(K_[off], bS, P0a[tb]); } }
#pragma unroll
            for (int ks = 0; ks < 4; ++ks) {
                u32x4 w; w.x = pk2(Sacc[2 * ks][0], Sacc[2 * ks][1]); w.y = pk2(Sacc[2 * ks][2], Sacc[2 * ks][3]); w.z = pk2(Sacc[2 * ks + 1][0], Sacc[2 * ks + 1][1]); w.w = pk2(Sacc[2 * ks + 1][2], Sacc[2 * ks + 1][3]);
                const bf16x8 bSb = __builtin_bit_cast(bf16x8, w);
#pragma unroll
                for (int tb = 0; tb < 2; ++tb) { const LAS unsigned char* qp = QB + ((16 * tb + m) * 136 + 32 * ks + 4 * g) * 2;
                    const s16x4 lo = *(const LAS s16x4*)qp, hi = *(const LAS s16x4*)(qp + 32);
                    PQa[tb] = __builtin_amdgcn_mfma_f32_16x16x32_bf16(__builtin_shufflevector(lo, hi, 0, 1, 2, 3, 4, 5, 6, 7), bSb, PQa[tb], 0, 0, 0); } }
        } else {
            const int gw4 = wave - 4, tb = gw4 & 1; const LAS unsigned char* XB = (gw4 >> 1) ? QB : KB; LAS float* OUT = (gw4 >> 1) ? HM : GM;
            f32x4 acc[2] = {(f32x4){0.f, 0.f, 0.f, 0.f}, (f32x4){0.f, 0.f, 0.f, 0.f}};
#pragma unroll
            for (int ks = 0; ks < 4; ++ks) { const bf16x8 aX = *(const LAS bf16x8*)(XB + ((16 * tb + m) * 136 + 32 * ks + 8 * g) * 2);
#pragma unroll
                for (int jb = 0; jb < 2; ++jb) acc[jb] = __builtin_amdgcn_mfma_f32_16x16x32_bf16(aX, *(const LAS bf16x8*)(KB + ((16 * jb + m) * 136 + 32 * ks + 8 * g) * 2), acc[jb], 0, 0, 0); }
#pragma unroll
            for (int jb = 0; jb < 2; ++jb)
#pragma unroll
                for (int i = 0; i < 4; ++i) OUT[(16 * tb + 4 * g + i) * 33 + 16 * jb + m] = acc[jb][i];
            if (wave == 4 && lane == 0) { float s = 0.f;
                for (int t = 0; t < 32; ++t) { s += AB_[2 * t]; GC_[t] = s; }
                for (int t = 0; t < 32; ++t) E31_[t] = __expf(s - GC_[t]); }
        }
        lds_barrier();
#pragma unroll
        for (int rep = 0; rep < 2; ++rep) { const int e = tid + 512 * rep, t = e >> 5, j = e & 31;
            const float d = __expf(GC_[t] - GC_[j]);
            BM[t * 32 + j] = (j < t) ? AB_[2 * t + 1] * d * GM[t * 33 + j] : 0.f;
            M2[t * 33 + j] = (j <= t) ? d * HM[t * 33 + j] : 0.f; }
        lds_barrier();
        if (wave < 4) {
            const int cw16 = 16 * wave;
#pragma unroll
            for (int tb = 0; tb < 2; ++tb)
#pragma unroll
                for (int i = 0; i < 4; ++i) { const int t = 16 * tb + 4 * g + i;
                    RH[t * 64 + cw16 + m] = AB_[2 * t + 1] * (V_[t * 64 + cw16 + m] - __expf(GC_[t]) * P0a[tb][i]); }
            LDS_WAIT(); asm volatile("" ::: "memory");
            if (lane < 16) {
                float cc[32];
                const int rowi = cw16 + lane;
#pragma unroll
                for (int tb8 = 0; tb8 < 4; ++tb8) {
                    float acc[8];
#pragma unroll
                    for (int r = 0; r < 8; ++r) acc[r] = RH[(8 * tb8 + r) * 64 + rowi];
#pragma unroll
                    for (int jb = 0; jb < tb8; ++jb)
#pragma unroll
                        for (int r = 0; r < 8; ++r) { const f32x4 b0 = *(const LAS f32x4*)(BM + (8 * tb8 + r) * 32 + 8 * jb), b1 = *(const LAS f32x4*)(BM + (8 * tb8 + r) * 32 + 8 * jb + 4);
                            acc[r] -= ((b0[0] * cc[8 * jb] + b0[1] * cc[8 * jb + 1]) + (b0[2] * cc[8 * jb + 2] + b0[3] * cc[8 * jb + 3])) + ((b1[0] * cc[8 * jb + 4] + b1[1] * cc[8 * jb + 5]) + (b1[2] * cc[8 * jb + 6] + b1[3] * cc[8 * jb + 7])); }
#pragma unroll
                    for (int rh = 0; rh < 2; ++rh) {
                        f32x4 d0[4], d1[4];
#pragma unroll
                        for (int r = 0; r < 4; ++r) { d0[r] = *(const LAS f32x4*)(BM + (8 * tb8 + 4 * rh + r) * 32 + 8 * tb8); if (rh) d1[r] = *(const LAS f32x4*)(BM + (8 * tb8 + 4 * rh + r) * 32 + 8 * tb8 + 4); }
#pragma unroll
                        for (int r = 0; r < 4; ++r) { float av = acc[4 * rh + r];
#pragma unroll
                            for (int q = 0; q < 8; ++q) if (q < 4 * rh + r) av -= (q < 4 ? d0[r][q & 3] : d1[r][q & 3]) * cc[8 * tb8 + q];
                            cc[8 * tb8 + 4 * rh + r] = av; CC[(8 * tb8 + 4 * rh + r) * 64 + rowi] = av; }
                    }
                }
            }
            LDS_WAIT(); asm volatile("" ::: "memory");
            float bC[8];
#pragma unroll
            for (int js = 0; js < 8; ++js) bC[js] = CC[(4 * js + g) * 64 + cw16 + m];
#pragma unroll
            for (int tb = 0; tb < 2; ++tb) { f32x4 o;
#pragma unroll
                for (int i = 0; i < 4; ++i) o[i] = PQa[tb][i] * __expf(GC_[16 * tb + 4 * g + i]);
#pragma unroll
                for (int js = 0; js < 8; ++js) o = MFMA16F(M2[(16 * tb + m) * 33 + 4 * js + g], bC[js], o);
#pragma unroll
                for (int i = 0; i < 4; ++i) ORAW[(tok_base + cidx * 32 + 16 * tb + 4 * g + i) * MIXW + vh * 128 + half * 64 + cw16 + m] = o[i]; }
            const float e31 = __expf(GC_[31]);
            float ej[8];
#pragma unroll
            for (int js = 0; js < 8; ++js) ej[js] = E31_[4 * js + g];
#pragma unroll
            for (int kb8 = 0; kb8 < 8; ++kb8) { f32x4 acc = Sacc[kb8] * e31;
#pragma unroll
                for (int js = 0; js < 8; ++js) acc = MFMA16F(K_[(4 * js + g) * KP + 16 * kb8 + m] * ej[js], bC[js], acc);
                Sacc[kb8] = acc; }
        }
        lds_barrier();
    }
#undef GD_COL
#undef GD_LOAD
#undef GD_WRITE
#undef GD_CONV4
#undef GD_DERIVE
}
DI void gdn_post_row(const float* ORAW, const float* P, const float* norm_g, bf16* YCAT, long tg, int lane) {
    const f32x2 g2 = *(const f32x2*)(norm_g + 2 * lane);
#pragma unroll 4
    for (int vh = 0; vh < 12; ++vh) {
        const f32x2 o = *(const f32x2*)(ORAW + tg * MIXW + vh * 128 + 2 * lane);
        const f32x2 z = *(const f32x2*)(P + tg * 5376 + 3072 + vh * 128 + 2 * lane);
        const float rs = frsq(wave_sum(o.x * o.x + o.y * o.y) * (1.f / 128.f) + 1e-6f);
        *(unsigned*)(YCAT + tg * DM + vh * 128 + 2 * lane) = pk2(o.x * rs * g2.x * siluf_(z.x), o.y * rs * g2.y * siluf_(z.y));
    }
}

DI void ffn_conv_task(const bf16* UP, const float* cw, bf16* ACT, int task) {
    const int cg8 = task % 704, strip = task / 704, c = cg8 * 8;
    const long t0 = (long)strip * 32;
    f32x4 wg[3][2], wv[3][2];
#pragma unroll
    for (int j = 0; j < 3; ++j) { wg[j][0] = *(const f32x4*)(cw + j * 11264 + c); wg[j][1] = *(const f32x4*)(cw + j * 11264 + c + 4);
        wv[j][0] = *(const f32x4*)(cw + j * 11264 + 5632 + c); wv[j][1] = *(const f32x4*)(cw + j * 11264 + 5632 + c + 4); }
    u32x4 g2 = {0u, 0u, 0u, 0u}, g1 = g2, v2 = g2, v1 = g2;
    if ((t0 & (SEQ - 1)) != 0) {
        g2 = *(const u32x4*)(UP + (t0 - 2) * 11264 + c); v2 = *(const u32x4*)(UP + (t0 - 2) * 11264 + 5632 + c);
        g1 = *(const u32x4*)(UP + (t0 - 1) * 11264 + c); v1 = *(const u32x4*)(UP + (t0 - 1) * 11264 + 5632 + c);
    }
#pragma unroll 4
    for (int i = 0; i < 32; ++i) {
        const long t = t0 + i;
        const u32x4 g0 = *(const u32x4*)(UP + t * 11264 + c), v0 = *(const u32x4*)(UP + t * 11264 + 5632 + c);
        u32x4 o;
#pragma unroll
        for (int q = 0; q < 4; ++q) {
            const int hf = q >> 1, e0 = (q & 1) * 2;
            const float ug0 = wg[0][hf][e0] * bflo(g2[q]) + wg[1][hf][e0] * bflo(g1[q]) + wg[2][hf][e0] * bflo(g0[q]);
            const float ug1 = wg[0][hf][e0 + 1] * bfhi(g2[q]) + wg[1][hf][e0 + 1] * bfhi(g1[q]) + wg[2][hf][e0 + 1] * bfhi(g0[q]);
            const float uv0 = wv[0][hf][e0] * bflo(v2[q]) + wv[1][hf][e0] * bflo(v1[q]) + wv[2][hf][e0] * bflo(v0[q]);
            const float uv1 = wv[0][hf][e0 + 1] * bfhi(v2[q]) + wv[1][hf][e0 + 1] * bfhi(v1[q]) + wv[2][hf][e0 + 1] * bfhi(v0[q]);
            o[q] = pk2(siluf_(ug0) * uv0, siluf_(ug1) * uv1);
        }
        *(u32x4*)(ACT + t * DFF + c) = o;
        g2 = g1; g1 = g0; v2 = v1; v1 = v0;
    }
}

#define XB_TMO      128
#define XB_XCNT(j)  (256  + 64 * (j))
#define XB_XSUB(j)  (1280 + 64 * (j))
#define XB_XGEN(j)  (2304 + 64 * (j))
#define XB_TOP      3328
#define XB_TOPGEN   3392
#define XCD_BAR_WORDS 3456
#define XB_SPIN_CAP (1u << 18)

__device__ __forceinline__ unsigned xb_ld(unsigned* p)              { return __hip_atomic_load(p, __ATOMIC_RELAXED, __HIP_MEMORY_SCOPE_AGENT); }
__device__ __forceinline__ unsigned xb_add(unsigned* p, unsigned v) { return __hip_atomic_fetch_add(p, v, __ATOMIC_RELAXED, __HIP_MEMORY_SCOPE_AGENT); }
__device__ __forceinline__ bool xb_tid0() { int t_ = threadIdx.x; asm volatile("" : "+v"(t_)); return t_ == 0; }
__device__ __forceinline__ unsigned xb_xcc_id() { return (unsigned)__builtin_amdgcn_s_getreg((3 << 11) | 20) & 0xFu; }
#define XB_SPIN(cond, bar) do { unsigned _sp = 0; while (cond) { __builtin_amdgcn_s_sleep(1); \
    if ((++_sp & 255u) == 0u) { if (xb_ld(&(bar)[XB_TMO])) break; if (_sp > XB_SPIN_CAP) { atomicAdd(&(bar)[XB_TMO], 1u); break; } } } } while (0)

struct XcdBarrier {
    unsigned* bar; unsigned x;
    volatile LAS unsigned* st;
};

__device__ __forceinline__ XcdBarrier xcd_barrier_post(unsigned* bar, volatile LAS unsigned* st) {
    XcdBarrier b; b.bar = bar; b.x = xb_xcc_id(); b.st = st;
    if (xb_tid0()) (void)xb_add(&bar[XB_XCNT(b.x)], 1u);
    return b;
}
__device__ __forceinline__ void xcd_barrier_complete(unsigned* bar, unsigned x, unsigned& nloc, unsigned& nx) {
    const unsigned G = gridDim.x * gridDim.y * gridDim.z;
    unsigned sum, cnt, mine, sp = 0u;
    for (;;) {
        sum = 0u; cnt = 0u; mine = 0u;
#pragma unroll
        for (unsigned j = 0; j < 16; ++j) { const unsigned c = xb_ld(&bar[XB_XCNT(j)]); sum += c; cnt += (c > 0u) ? 1u : 0u; mine = (j == x) ? c : mine; }
        if (sum == G) break;
        __builtin_amdgcn_s_sleep(1);
        if ((++sp & 255u) == 0u) { if (xb_ld(&bar[XB_TMO])) break; if (sp > XB_SPIN_CAP) { atomicAdd(&bar[XB_TMO], 1u); break; } }
    }
    nloc = mine > 0u ? mine : 1u; nx = cnt > 0u ? cnt : 1u;
}

__device__ __forceinline__ void xcd_barrier(const XcdBarrier& b) {
    asm volatile("s_waitcnt vmcnt(0)" ::: "memory");
    __syncthreads();
    if (xb_tid0()) {
        unsigned* bar = b.bar;
        __builtin_amdgcn_s_waitcnt(0);
        unsigned nloc = b.st[0], nx = b.st[1];
        if (nloc == 0u) { xcd_barrier_complete(bar, b.x, nloc, nx); b.st[0] = nloc; b.st[1] = nx; }
        const unsigned old = xb_add(&bar[XB_XSUB(b.x)], 1u);
        const unsigned gen = old / nloc;
        if (old + 1u == (gen + 1u) * nloc) {
            __builtin_amdgcn_fence(__ATOMIC_RELEASE, "agent");
            asm volatile("s_waitcnt vmcnt(0)" ::: "memory");
            const unsigned og = xb_add(&bar[XB_TOP], 1u);
            const unsigned tg = og / nx;
            if (og + 1u == (tg + 1u) * nx) xb_add(&bar[XB_TOPGEN], 1u);
            else XB_SPIN(xb_ld(&bar[XB_TOPGEN]) == tg, bar);
            __builtin_amdgcn_fence(__ATOMIC_ACQUIRE, "agent");
            xb_add(&bar[XB_XGEN(b.x)], 1u);
            asm volatile("s_waitcnt vmcnt(0)" ::: "memory");
        } else {
            XB_SPIN(xb_ld(&bar[XB_XGEN(b.x)]) == gen, bar);
            __builtin_amdgcn_fence(__ATOMIC_ACQUIRE, "agent");
            asm volatile("s_waitcnt vmcnt(0)" ::: "memory");
        }
    }
    __syncthreads();
}

constexpr int LDS_BAR_ST = LDS_BYTES - 64;

struct Args { const float* in[30]; float* out; unsigned char* ws; int lo, hi; };
typedef const __attribute__((address_space(4))) Args* KArgs;
struct Ctx {
    KArgs ap; unsigned char* ws; LAS unsigned char* lds;
    int tid, lane, wave, G, bid, gw, NGW;
    bf16 *WT_IN, *WT_MKV, *WT_OUT, *WT_UP, *WT_DOWN, *WT_LORA, *H, *YCAT, *MEMN, *LORAIN, *UP, *ACT;
    float *X, *MEMKV, *P, *LO, *ORAW, *SSA, *SSF;
};
DI Ctx make_ctx(LAS unsigned char* lds, int layer) {
    Ctx c;
    KArgs ap = (KArgs)__builtin_amdgcn_kernarg_segment_ptr(); asm volatile("" : "+s"(ap));
    int tid = threadIdx.x; asm volatile("" : "+v"(tid));
    int bid = blockIdx.x; asm volatile("" : "+s"(bid));
    c.ap = ap; { unsigned l_ = (unsigned)(uintptr_t)lds; asm volatile("" : "+s"(l_)); c.lds = (LAS unsigned char*)(uintptr_t)l_; } c.tid = tid; c.lane = tid & 63; c.wave = __builtin_amdgcn_readfirstlane(tid >> 6); int G_ = gridDim.x; asm volatile("" : "+s"(G_)); c.G = G_; c.bid = bid; c.gw = bid * 8 + c.wave; c.NGW = c.G * 8;
    unsigned char* ws = ap->ws; c.ws = ws;
    { unsigned char* wsw = ws + ((layer & 1) ? WS_WSET1 : 0);
    c.WT_IN = (bf16*)(wsw + WS_WIN); c.WT_MKV = (bf16*)(wsw + WS_WMKV); c.WT_OUT = (bf16*)(wsw + WS_WOUT); c.WT_UP = (bf16*)(wsw + WS_WUP); c.WT_DOWN = (bf16*)(wsw + WS_WDOWN); c.WT_LORA = (bf16*)(wsw + WS_WLORA); }
    c.X = (float*)(ws + WS_X); c.H = (bf16*)(ws + WS_H); c.YCAT = (bf16*)(ws + WS_YCAT); c.MEMN = (bf16*)(ws + WS_MEMN4 + (size_t)layer * 8 * MiB); c.MEMKV = (float*)(ws + WS_MEMKV);
    c.LORAIN = (bf16*)(ws + WS_LORAIN); c.P = (float*)(ws + WS_P); c.LO = (float*)(ws + WS_LO); c.UP = (bf16*)(ws + WS_P); c.ACT = (bf16*)(ws + WS_LO); c.ORAW = (float*)(ws + WS_LO); c.SSA = (float*)(ws + WS_SSPA); c.SSF = (float*)(ws + WS_SSPF);
    return c;
}
#define INP(k) ((const float*)c.ap->in[k])
DI int nin_of(int kind) { return kind == 0 ? 2560 : kind == 1 ? 5568 : 5144; }
DI int npad_of(int kind) { return kind == 0 ? 2560 : kind == 1 ? 5632 : 5376; }
DI int qoff_of(int kind) { return kind == 0 ? 2048 : kind == 1 ? 5056 : 4632; }

DI void convert_layer_weights(const Ctx& c, int layer, int gw, int NGW, int which) {
    const int kind = layer % 3, jj = layer / 3;
    unsigned char* wsw = c.ws + ((layer & 1) ? WS_WSET1 : 0);
    const float* w_in = kind == 0 ? INP(11) + (size_t)jj * 2048 * 2560 : kind == 1 ? INP(13) : INP(25);
    LAS float* scr = (LAS float*)(c.lds + c.wave * 16640);
    if (which & 1) transpose_weight(w_in, 2048, nin_of(kind), npad_of(kind), (bf16*)(wsw + WS_WIN), scr, gw, NGW, c.lane);
    if (which & 2) transpose_weight(INP(4) + (size_t)layer * 2048 * 1024, 2048, 1024, 1024, (bf16*)(wsw + WS_WMKV), scr, gw, NGW, c.lane);
    if (which & 4) transpose_weight(INP(5) + (size_t)layer * 2048 * 2048, 2048, 2048, 2048, (bf16*)(wsw + WS_WOUT), scr, gw, NGW, c.lane);
    if (which & 8) transpose_weight(INP(7) + (size_t)layer * 2048 * 11264, 2048, 11264, 11264, (bf16*)(wsw + WS_WUP), scr, gw, NGW, c.lane, true);
    if (which & 16) transpose_weight(INP(9) + (size_t)layer * 5632 * 2048, 5632, 2048, 2048, (bf16*)(wsw + WS_WDOWN), scr, gw, NGW, c.lane);
    if (kind == 1 && (which & 32)) {
        const float *wd = INP(16), *wa = INP(18), *wg = INP(19); bf16* WL = (bf16*)(wsw + WS_WLORA);
        for (int idx = gw * 64 + c.lane; idx < 4608 * 64; idx += NGW * 64) { const int n = idx >> 6, k0 = (idx & 63) * 8;
            u32x4 o; o.x = pk2(lora_w(wd, wa, wg, n, k0), lora_w(wd, wa, wg, n, k0 + 1)); o.y = pk2(lora_w(wd, wa, wg, n, k0 + 2), lora_w(wd, wa, wg, n, k0 + 3));
            o.z = pk2(lora_w(wd, wa, wg, n, k0 + 4), lora_w(wd, wa, wg, n, k0 + 5)); o.w = pk2(lora_w(wd, wa, wg, n, k0 + 6), lora_w(wd, wa, wg, n, k0 + 7));
            *(u32x4*)(WL + (size_t)n * 512 + k0) = o; }
    }
}
DI void phase_prep(const Ctx& c) {
    convert_layer_weights(c, 0, c.gw, c.NGW, 0x3f);
    convert_layer_weights(c, 1, c.gw, c.NGW, 0x23);
    { const float* gn = INP(2); const float* x0 = INP(0);
      for (int m = c.gw; m < T; m += c.NGW) xg_row(x0 + (size_t)m * DM, gn, c.H + (size_t)m * DM, c.SSA + (size_t)m * 32, c.lane); }
    const float* mem = INP(1);
    for (int m = c.gw; m < 4 * NBATCH * MEML; m += c.NGW) { const int l = m / (NBATCH * MEML), r = m - l * (NBATCH * MEML);
        rms_row_bf16(mem + (size_t)r * DM, INP(3) + l * DM, (bf16*)(c.ws + WS_MEMN4 + (size_t)l * 8 * MiB) + (size_t)r * DM, c.lane); }
}
DI void phase_inproj(const Ctx& c, int layer) {
    const int Npad = npad_of(layer % 3);
    { pg8::Gemm g{c.H, c.WT_IN, T, Npad, 2048}; pg8::StaticOrder S; S.init(T, Npad, c.G, c.bid); pg8::EpiF32 E{c.P, Npad, c.SSA};
      pg8::gemm_phase<pg8::EpiF32, pg8::StaticOrder, true, true>(c.lds, g, S, E); }
    { const int rem = ((T / 256) * (Npad / 256)) % c.G; const int c2 = (c.bid - rem + c.G) % c.G;
      pg8::Gemm g{c.MEMN, c.WT_MKV, NBATCH * MEML, 1024, 2048}; pg8::StaticOrder S; S.init(NBATCH * MEML, 1024, c.G, c2); pg8::EpiF32 E{c.MEMKV, 1024, nullptr};
      pg8::gemm_phase<pg8::EpiF32, pg8::StaticOrder, true, true>(c.lds, g, S, E); }
}
DI void phase_swa(const Ctx& c, int layer) {
    const float* sinks = INP(12) + (layer / 3) * 24;
    for (int it = c.bid; it < 512; it += c.G) swa_item(c.lds, it, c.P, 2560, sinks, c.YCAT, c.tid, c.lane, c.wave);
    for (int it = c.bid; it < 256; it += c.G) mem_item(c.lds, it, c.P, 2560, 2048, c.MEMKV, c.YCAT, c.tid, c.lane, c.wave);
}
DI void phase_rwkv_prep(const Ctx& c) {
    const float* mu = INP(14);
    for (long m = c.gw; m < T; m += c.NGW) rwkv_prep_row(c.P, mu, c.LORAIN, m, c.lane);
}
DI void phase_rwkv_lora(const Ctx& c) {
    pg8::Gemm g{c.LORAIN, c.WT_LORA, T, 4608, 512}; pg8::StaticOrder S; S.init(T, 4608, c.G, c.bid); pg8::EpiF32 E{c.LO, 4608, nullptr};
    pg8::gemm_phase<pg8::EpiF32, pg8::StaticOrder, true, true>(c.lds, g, S, E);
}
DI void phase_rwkv_scan(const Ctx& c) {
    if (c.bid < 192) { const RwkvPar pr{INP(14), INP(15), INP(17), INP(20), INP(21), INP(22), INP(23), INP(24)}; rwkv_scan_block(c.lds, c.bid, c.P, c.LO, pr, c.YCAT, c.tid, c.lane, c.wave); }
    else { for (int it = c.bid - 192; it < 256; it += c.G - 192) mem_item(c.lds, it, c.P, 5632, 5056, c.MEMKV, c.YCAT, c.tid, c.lane, c.wave);
        __syncthreads(); convert_layer_weights(c, 1, (c.bid - 192) * 8 + c.wave, (c.G - 192) * 8, 0x1c); convert_layer_weights(c, 2, (c.bid - 192) * 8 + c.wave, (c.G - 192) * 8, 0x03); }
}
DI void phase_gdn_scan(const Ctx& c) {
    if (c.bid < 192) { const GdnPar pr{INP(26), INP(27), INP(28)}; gdn_scan_block(c.lds, c.bid, c.P, pr, c.ORAW, c.tid, c.lane, c.wave); }
    else { for (int it = c.bid - 192; it < 256; it += c.G - 192) mem_item(c.lds, it, c.P, 5376, 4632, c.MEMKV, c.YCAT, c.tid, c.lane, c.wave);
        __syncthreads(); convert_layer_weights(c, 2, (c.bid - 192) * 8 + c.wave, (c.G - 192) * 8, 0x1c); convert_layer_weights(c, 3, (c.bid - 192) * 8 + c.wave, (c.G - 192) * 8, 0x3f); }
}
DI void phase_gdn_post(const Ctx& c) {
    const float* ng = INP(29);
    for (long m = c.gw; m < T; m += c.NGW) gdn_post_row(c.ORAW, c.P, ng, c.YCAT, m, c.lane);
}
DI void phase_outproj(const Ctx& c, int layer) {
    const float* xsrc = layer == 0 ? INP(0) : c.X;
    pg8::Gemm g{c.YCAT, c.WT_OUT, T, 2048, 2048}; pg8::StaticOrder S; S.init(T, 2048, c.G, c.bid); pg8::EpiResNorm E{xsrc, c.X, 2048, INP(6) + layer * DM, c.H, c.SSF};
    pg8::gemm_phase<pg8::EpiResNorm, pg8::StaticOrder, true, true>(c.lds, g, S, E);
}
DI void phase_ffn_up(const Ctx& c, int layer) {
    pg8::Gemm g{c.H, c.WT_UP, T, 11264, 2048}; pg8::StaticOrder S; S.init(T, 11264, c.G, c.bid);
    pg8::EpiUpConv E{c.ACT, c.SSF, INP(8) + (size_t)layer * 3 * 11264, (float*)(c.ws + WS_RAWB), c.lds + 131072};
    pg8::gemm_phase<pg8::EpiUpConv, pg8::StaticOrder, true, true>(c.lds, g, S, E);
}
DI void ffn_fix_tile(const Ctx& c, const float* cw, int pm) {
    if ((pm & 7) == 0) return;
    const float* RAWB = (const float*)(c.ws + WS_RAWB);
    for (int idx = c.tid; idx < 2 * 1408; idx += 512) {
        const int r = idx / 1408, c4 = idx - r * 1408, col = 4 * c4;
        const float* cur_t = RAWB + ((size_t)pm * 4 + r) * 11264;
        const float* p1_t = r == 0 ? RAWB + ((size_t)(pm - 1) * 4 + 3) * 11264 : RAWB + ((size_t)pm * 4 + 0) * 11264;
        const float* p2_t = r == 0 ? RAWB + ((size_t)(pm - 1) * 4 + 2) * 11264 : RAWB + ((size_t)(pm - 1) * 4 + 3) * 11264;
        f32x4 ug = *(const f32x4*)(cw + col) * *(const f32x4*)(p2_t + col) + *(const f32x4*)(cw + 11264 + col) * *(const f32x4*)(p1_t + col) + *(const f32x4*)(cw + 2 * 11264 + col) * *(const f32x4*)(cur_t + col);
        f32x4 uv = *(const f32x4*)(cw + 5632 + col) * *(const f32x4*)(p2_t + 5632 + col) + *(const f32x4*)(cw + 11264 + 5632 + col) * *(const f32x4*)(p1_t + 5632 + col) + *(const f32x4*)(cw + 2 * 11264 + 5632 + col) * *(const f32x4*)(cur_t + 5632 + col);
        u32x2 o; o.x = pk2(siluf_(ug.x) * uv.x, siluf_(ug.y) * uv.y); o.y = pk2(siluf_(ug.z) * uv.z, siluf_(ug.w) * uv.w);
        *(u32x2*)(c.ACT + ((size_t)pm * 256 + r) * DFF + col) = o;
    }
}
DI void phase_ffn_down(const Ctx& c, int layer) {
    const float* gnext = layer < 3 ? INP(2) + (layer + 1) * DM : INP(10);
    pg8::Gemm g{c.ACT, c.WT_DOWN, T, 2048, 5632}; pg8::StaticOrder S; S.init(T, 2048, c.G, c.bid);
    {
        const float* cw = INP(8) + (size_t)layer * 3 * 11264; pg8::Unit u; int last_pm = -1;
        for (int i = 0; S.next(i, u); ++i) if (u.pm != last_pm) { ffn_fix_tile(c, cw, u.pm); last_pm = u.pm; }
        asm volatile("s_waitcnt vmcnt(0)" ::: "memory"); __syncthreads();
    } pg8::EpiResNorm E{c.X, layer < 3 ? c.X : nullptr, 2048, gnext, c.H, c.SSA};
    pg8::gemm_phase<pg8::EpiResNorm, pg8::StaticOrder, true, true>(c.lds, g, S, E);
}
DI void phase_final(const Ctx& c) {
    float* out = c.ap->out;
    for (int m = c.gw; m < T; m += c.NGW) {
        const float part = c.lane < 32 ? c.SSA[(size_t)m * 32 + c.lane] : 0.f;
        const float rs = frsq(wave_sum(part) * (1.f / 2048.f) + 1e-6f);
        const u32x4* xg = (const u32x4*)(c.H + (size_t)m * DM) + c.lane;
        f32x4* o = (f32x4*)(out + (size_t)m * DM) + 2 * c.lane;
#pragma unroll
        for (int j = 0; j < 4; ++j) { const u32x4 w = xg[64 * j];
            o[128 * j] = (f32x4){bflo(w.x) * rs, bfhi(w.x) * rs, bflo(w.y) * rs, bfhi(w.y) * rs};
            o[128 * j + 1] = (f32x4){bflo(w.z) * rs, bfhi(w.z) * rs, bflo(w.w) * rs, bfhi(w.w) * rs}; }
    }
}

__global__ void __launch_bounds__(512, 2) mega_fwd(Args args) {
    extern __shared__ __attribute__((aligned(16))) unsigned char lds_raw[];
    LAS unsigned char* lds = (LAS unsigned char*)lds_raw;
    cg::grid_group grid = cg::this_grid();
    const int lo = args.lo, hi = args.hi;
    int ph = 0;
    if (hi - lo > 1) {
        volatile LAS unsigned* st = (volatile LAS unsigned*)(lds + LDS_BAR_ST);
        if (threadIdx.x == 0) { st[0] = 0u; st[1] = 0u; }
        __syncthreads();
        (void)xcd_barrier_post((unsigned*)args.ws, st);
    }
#define PHASE(call) do { if (ph >= lo && ph < hi) { { const Ctx c = make_ctx(lds, layer); call; } if (ph + 1 < hi) { if (hi == -7) grid.sync();   else { XcdBarrier xb_; xb_.bar = (unsigned*)make_ctx(lds, 0).ws; xb_.x = xb_xcc_id(); xb_.st = (volatile LAS unsigned*)(make_ctx(lds, 0).lds + LDS_BAR_ST); xcd_barrier(xb_); } } } ++ph; } while (0)
#pragma unroll 1
    for (int layer = 0; layer < 4; ++layer) {
        const int kind = layer % 3;
        if (layer == 0) PHASE(phase_prep(c));
        PHASE(phase_inproj(c, layer));
        if (kind == 0) {
            PHASE(phase_swa(c, layer));
        } else if (kind == 1) {
            PHASE(phase_rwkv_prep(c));
            PHASE(phase_rwkv_lora(c));
            PHASE(phase_rwkv_scan(c));
        } else {
            PHASE(phase_gdn_scan(c));
            PHASE(phase_gdn_post(c));
        }
        PHASE(phase_outproj(c, layer));
        PHASE(phase_ffn_up(c, layer));
        PHASE(phase_ffn_down(c, layer));
    }
    { const int layer = 0; PHASE(phase_final(c)); }
#undef PHASE
}

#ifndef MK_COOP
#define MK_COOP 1
#endif
extern "C" void kernel_launch(void* const* d_in, const int* in_sizes, int n_in, void* d_out, int out_size, void* d_ws, size_t ws_size, hipStream_t stream) {
    static int grid = 0;
    if (grid == 0) {
        if (n_in != 30 || out_size != T * DM || ws_size < WS_END) { fprintf(stderr, "kernel_launch: unexpected problem (n_in %d out %d ws %zu)\n", n_in, out_size, ws_size); grid = -1; return; }
        int dev = 0, cus = 0, per_cu = 0;
        hipGetDevice(&dev); hipDeviceGetAttribute(&cus, hipDeviceAttributeMultiprocessorCount, dev);
        if (hipFuncSetAttribute((const void*)mega_fwd, hipFuncAttributeMaxDynamicSharedMemorySize, LDS_BYTES) != hipSuccess) { fprintf(stderr, "kernel_launch: hipFuncSetAttribute failed\n"); grid = -1; return; }
        hipOccupancyMaxActiveBlocksPerMultiprocessor(&per_cu, (const void*)mega_fwd, 512, LDS_BYTES);
        (void)hipGetLastError();
        if (per_cu < 1) { fprintf(stderr, "kernel_launch: occupancy query says %d blocks per CU\n", per_cu); per_cu = 1; }
        grid = cus * 1;
        if (grid <= 192) { fprintf(stderr, "kernel_launch: this kernel needs more than 192 CUs (got %d)\n", grid); grid = -1; return; }
        fprintf(stderr, "kernel_launch: grid %d (cus %d, per_cu %d)\n", grid, cus, per_cu);
    }
    if (grid < 0) return;
    Args a{};
    for (int i = 0; i < 30; ++i) a.in[i] = (const float*)d_in[i];
    a.out = (float*)d_out; a.ws = (unsigned char*)d_ws;
#if MK_COOP
    if (hipMemsetAsync(d_ws, 0, XCD_BAR_WORDS * 4, stream) != hipSuccess) { fprintf(stderr, "kernel_launch: hipMemsetAsync of the barrier words failed\n"); return; }
    a.lo = 0; a.hi = 1 << 20;
    void* kargs[] = {&a};
    hipError_t e = hipLaunchCooperativeKernel((const void*)mega_fwd, dim3(grid), dim3(512), kargs, LDS_BYTES, stream);
    if (e != hipSuccess) fprintf(stderr, "kernel_launch: cooperative launch failed: %s (grid %d)\n", hipGetErrorString(e), grid);
#else
    for (int p = 0; p < NPH; ++p) { a.lo = p; a.hi = p + 1; hipLaunchKernelGGL(mega_fwd, dim3(grid), dim3(512), LDS_BYTES, stream, a); }
#endif
}
```

```cpp
#include <hip/hip_runtime.h>
#include <hip/hip_cooperative_groups.h>
#include <cstdio>
#include <cstdint>
namespace cg = cooperative_groups;
namespace pg8 {
#define PG8_LAS __attribute__((address_space(3)))
typedef unsigned short bf16_t;
typedef short bf16x8 __attribute__((ext_vector_type(8)));
typedef float f32x4 __attribute__((ext_vector_type(4)));
typedef unsigned u32x4 __attribute__((ext_vector_type(4)));
constexpr int BM = 256, BK = 64, HALF = 128, HTB = HALF * BK * 2  , STAGE_BYTES = 8 * HTB, NXCD = 8, WGM = 4;

__host__ __device__ __forceinline__ int lds_byte(int r, int c) { const int st = (r >> 4) * 2 + (c >> 5), rr = r & 15, cc = c & 31, ob = rr * 64 + cc * 2; return st * 1024 + (ob ^ (((ob >> 9) & 1) << 5)); }
__host__ __device__ __forceinline__ void stage_rc(int b, int& R, int& C) { const int st = b / 1024, sb = b % 1024, swz = sb ^ (((sb >> 9) & 1) << 5); R = (st >> 1) * 16 + swz / 64; C = (st & 1) * 32 + (swz % 64) / 2; }
__host__ __device__ __forceinline__ int perm32(int rho) { const int n = rho >> 4, i = rho & 15; return 8 * (i >> 2) + 4 * n + (i & 3); }

struct Unit { int pm, pn; };
struct Gemm { const bf16_t* A; const bf16_t* Bt; int M, N, K; };

struct StaticOrder {
    int nM, nN, nwg, G, c;
    __host__ __device__ void init(int M, int N, int G_, int c_) { nM = M / BM; nN = N / BM; nwg = nM * nN; G = G_; c = c_; }
    __host__ __device__ bool next(int i, Unit& u) const {
        const long L = (long)i * G + c; if (L >= nwg) return false;
        int wgid = (int)L; { const int q = nwg / NXCD, r = nwg % NXCD, xcd = wgid % NXCD, off = wgid / NXCD; wgid = (xcd < r ? xcd * (q + 1) : r * (q + 1) + (xcd - r) * q) + off; }
        const int nig = WGM * nN, gid = wgid / nig, fm = gid * WGM, gsz = (nM - fm) < WGM ? (nM - fm) : WGM;
        u.pm = fm + ((wgid % nig) % gsz); u.pn = (wgid % nig) / gsz; return true;
    }
    __device__ __forceinline__ void a_ready(const Unit&) const {}
    __device__ __forceinline__ void done(const Unit&) const {}
};

__device__ __forceinline__ unsigned cvt_pk_bf16(float lo, float hi) { unsigned r; asm volatile("v_cvt_pk_bf16_f32 %0, %1, %2" : "=v"(r) : "v"(lo), "v"(hi)); return r; }
typedef unsigned u32x2v __attribute__((ext_vector_type(2)));
__device__ __forceinline__ float rs_from_partials(const float* SSP, int row, int fq) {
    const f32x4 a = *(const f32x4*)(SSP + (size_t)row * 32 + 8 * fq), b = *(const f32x4*)(SSP + (size_t)row * 32 + 8 * fq + 4);
    float s = ((a[0] + a[1]) + (a[2] + a[3])) + ((b[0] + b[1]) + (b[2] + b[3]));
    s += __shfl_xor(s, 16); s += __shfl_xor(s, 32);
    return __builtin_amdgcn_rsqf(s * (1.f / 2048.f) + 1e-6f);
}
struct EpiF32 {
    static constexpr bool PERM = false, AFTER_DRAIN = false;
    float* O; int ldc; const float* SS;
    __device__ __forceinline__ void operator()(const f32x4 (&acc)[2][2][4][2], const Unit& u, int wr, int wc, int fr, int fq) const {
#pragma unroll
        for (int ai = 0; ai < 2; ++ai)
#pragma unroll
            for (int m = 0; m < 4; ++m) { const int row = u.pm * BM + ai * HALF + wr * 64 + m * 16 + fr; float* rowp = O + (size_t)row * ldc + u.pn * BM + wc * 32 + 4 * fq;
                const float rs = SS ? rs_from_partials(SS, row, fq) : 1.f;
#pragma unroll
                for (int bj = 0; bj < 2; ++bj)
#pragma unroll
                    for (int n = 0; n < 2; ++n) *(f32x4*)(rowp + bj * HALF + n * 16) = acc[ai][bj][m][n] * rs; }
    }
};
struct EpiRes {
    static constexpr bool PERM = false, AFTER_DRAIN = false;
    const float* base; float* out; int ldc;
    __device__ __forceinline__ void operator()(const f32x4 (&acc)[2][2][4][2], const Unit& u, int wr, int wc, int fr, int fq) const {
#pragma unroll
        for (int ai = 0; ai < 2; ++ai)
#pragma unroll
            for (int m = 0; m < 4; ++m) { const size_t off = (size_t)(u.pm * BM + ai * HALF + wr * 64 + m * 16 + fr) * ldc + u.pn * BM + wc * 32 + 4 * fq;
#pragma unroll
                for (int bj = 0; bj < 2; ++bj)
#pragma unroll
                    for (int n = 0; n < 2; ++n) { const f32x4 b = *(const f32x4*)(base + off + bj * HALF + n * 16); *(f32x4*)(out + off + bj * HALF + n * 16) = b + acc[ai][bj][m][n]; }
                asm volatile("" ::: "memory"); }
    }
};
struct EpiB16 {
    static constexpr bool PERM = true, AFTER_DRAIN = false;
    bf16_t* O; int ldc; const float* SS;
    __device__ __forceinline__ void operator()(const f32x4 (&acc)[2][2][4][2], const Unit& u, int wr, int wc, int fr, int fq) const {
        const int row0 = u.pm * BM + wr * 64 + fr, col0 = u.pn * BM + wc * 32 + 8 * fq;
#pragma unroll
        for (int ai = 0; ai < 2; ++ai)
#pragma unroll
            for (int m = 0; m < 4; ++m) { const int row = row0 + ai * HALF + m * 16; bf16_t* rowp = O + (size_t)row * ldc + col0;
                const float rs = rs_from_partials(SS, row, fq);
#pragma unroll
                for (int bj = 0; bj < 2; ++bj) { const f32x4 v0 = acc[ai][bj][m][0] * rs, v1 = acc[ai][bj][m][1] * rs;
                    u32x4 w; w.x = cvt_pk_bf16(v0[0], v0[1]); w.y = cvt_pk_bf16(v0[2], v0[3]); w.z = cvt_pk_bf16(v1[0], v1[1]); w.w = cvt_pk_bf16(v1[2], v1[3]);
                    *(u32x4*)(rowp + bj * HALF) = w; } }
    }
};
struct EpiResNorm {
    static constexpr bool PERM = true, AFTER_DRAIN = false;
    const float* base; float* out; int ldc; const float* g; bf16_t* XG; float* SS;
    __device__ __forceinline__ void operator()(const f32x4 (&acc)[2][2][4][2], const Unit& u, int wr, int wc, int fr, int fq) const {
        const int row0 = u.pm * BM + wr * 64 + fr, col0 = u.pn * BM + wc * 32 + 8 * fq;
        f32x4 gv[2][2];
#pragma unroll
        for (int bj = 0; bj < 2; ++bj)
#pragma unroll
            for (int n = 0; n < 2; ++n) gv[bj][n] = *(const f32x4*)(g + col0 + bj * HALF + 4 * n);
#pragma unroll
        for (int ai = 0; ai < 2; ++ai) {
            f32x4 rb[4][2][2];
#pragma unroll
            for (int m = 0; m < 4; ++m) { const size_t off = (size_t)(row0 + ai * HALF + m * 16) * ldc + col0;
#pragma unroll
                for (int bj = 0; bj < 2; ++bj) { rb[m][bj][0] = *(const f32x4*)(base + off + bj * HALF); rb[m][bj][1] = *(const f32x4*)(base + off + bj * HALF + 4); } }
#pragma unroll
            for (int m = 0; m < 4; ++m) { const int row = row0 + ai * HALF + m * 16; const size_t off = (size_t)row * ldc + col0; float ss = 0.f;
#pragma unroll
                for (int bj = 0; bj < 2; ++bj) {
                    const f32x4 x0 = rb[m][bj][0] + acc[ai][bj][m][0], x1 = rb[m][bj][1] + acc[ai][bj][m][1];
                    if (out) { *(f32x4*)(out + off + bj * HALF) = x0; *(f32x4*)(out + off + bj * HALF + 4) = x1; }
                    ss += (x0[0] * x0[0] + x0[1] * x0[1]) + (x0[2] * x0[2] + x0[3] * x0[3]) + (x1[0] * x1[0] + x1[1] * x1[1]) + (x1[2] * x1[2] + x1[3] * x1[3]);
                    const f32x4 y0 = x0 * gv[bj][0], y1 = x1 * gv[bj][1];
                    u32x4 w; w.x = cvt_pk_bf16(y0[0], y0[1]); w.y = cvt_pk_bf16(y0[2], y0[3]); w.z = cvt_pk_bf16(y1[0], y1[1]); w.w = cvt_pk_bf16(y1[2], y1[3]);
                    *(u32x4*)(XG + off + bj * HALF) = w; }
                ss += __shfl_xor(ss, 16); ss += __shfl_xor(ss, 32);
                if (fq == 0) SS[(size_t)row * 32 + u.pn * 4 + wc] = ss; }
            asm volatile("" ::: "memory");
        }
    }
};
struct EpiUpConv {
    static constexpr bool PERM = true, AFTER_DRAIN = false;
    bf16_t* ACT; const float* SS; const float* cw; float* RAWB; PG8_LAS unsigned char* xch;
    static __device__ __forceinline__ float dpp_shr1(float old, float src) { return __builtin_bit_cast(float, __builtin_amdgcn_update_dpp(__builtin_bit_cast(int, old), __builtin_bit_cast(int, src), 0x111, 0xf, 0xf, false)); }
    static __device__ __forceinline__ float dpp_shr2(float old, float src) { return __builtin_bit_cast(float, __builtin_amdgcn_update_dpp(__builtin_bit_cast(int, old), __builtin_bit_cast(int, src), 0x112, 0xf, 0xf, false)); }
    static __device__ __forceinline__ float dpp_ror1(float src) { return __builtin_bit_cast(float, __builtin_amdgcn_update_dpp(0, __builtin_bit_cast(int, src), 0x121, 0xf, 0xf, true)); }
    static __device__ __forceinline__ float dpp_ror2(float src) { return __builtin_bit_cast(float, __builtin_amdgcn_update_dpp(0, __builtin_bit_cast(int, src), 0x122, 0xf, 0xf, true)); }
    __device__ __forceinline__ void operator()(const f32x4 (&acc)[2][2][4][2], const Unit& u, int wr, int wc, int fr, int fq) const {
        const int row0 = u.pm * BM + wr * 64 + fr, cidx = wc * 32 + 8 * fq;
        float rs[2][4];
#pragma unroll
        for (int ai = 0; ai < 2; ++ai)
#pragma unroll
            for (int m = 0; m < 4; ++m) rs[ai][m] = rs_from_partials(SS, row0 + ai * HALF + m * 16, fq);
#pragma unroll
        for (int ai = 0; ai < 2; ++ai) {
            const int gi = ai * 2 + wr;
            if (fr >= 14) {
                const int r = fr - 14;
#pragma unroll
                for (int bj = 0; bj < 2; ++bj)
#pragma unroll
                    for (int n = 0; n < 2; ++n) { const f32x4 v = acc[ai][bj][3][n] * rs[ai][3];
                        *(PG8_LAS f32x4*)(xch + ((((gi * 2 + r) * 2 + bj) * 128) + cidx + 4 * n) * 4) = v;
                        if (gi == 3) *(f32x4*)(RAWB + ((size_t)u.pm * 4 + 2 + r) * 11264 + bj * 5632 + u.pn * 128 + cidx + 4 * n) = v; }
            }
            if (gi == 0 && fr < 2) {
#pragma unroll
                for (int bj = 0; bj < 2; ++bj)
#pragma unroll
                    for (int n = 0; n < 2; ++n) *(f32x4*)(RAWB + ((size_t)u.pm * 4 + fr) * 11264 + bj * 5632 + u.pn * 128 + cidx + 4 * n) = acc[ai][bj][0][n] * rs[ai][0];
            }
        }
        asm volatile("s_waitcnt lgkmcnt(0)" ::: "memory"); __builtin_amdgcn_s_barrier(); asm volatile("" ::: "memory");
#pragma unroll
        for (int n = 0; n < 2; ++n) {
            f32x4 w[2][3];
#pragma unroll
            for (int bj = 0; bj < 2; ++bj)
#pragma unroll
                for (int j = 0; j < 3; ++j) w[bj][j] = *(const f32x4*)(cw + j * 11264 + bj * 5632 + u.pn * 128 + cidx + 4 * n);
#pragma unroll
            for (int ai = 0; ai < 2; ++ai) {
                const int gi = ai * 2 + wr;
                f32x4 o1[2], o2[2];
#pragma unroll
                for (int bj = 0; bj < 2; ++bj) {
                    o1[bj] = (f32x4){0.f, 0.f, 0.f, 0.f}; o2[bj] = o1[bj];
                    if (gi > 0) { o1[bj] = *(const PG8_LAS f32x4*)(xch + (((((gi - 1) * 2 + 1) * 2 + bj) * 128) + cidx + 4 * n) * 4);
                                  o2[bj] = *(const PG8_LAS f32x4*)(xch + (((((gi - 1) * 2 + (fr == 0 ? 0 : 1)) * 2 + bj) * 128) + cidx + 4 * n) * 4); }
                }
#pragma unroll
                for (int m = 0; m < 4; ++m) {
                    f32x4 uu[2];
#pragma unroll
                    for (int bj = 0; bj < 2; ++bj) { const f32x4 cur = acc[ai][bj][m][n] * rs[ai][m];
#pragma unroll
                        for (int q = 0; q < 4; ++q) { const float p1 = dpp_shr1(o1[bj][q], cur[q]), p2 = dpp_shr2(o2[bj][q], cur[q]);
                            uu[bj][q] = w[bj][0][q] * p2 + w[bj][1][q] * p1 + w[bj][2][q] * cur[q];
                            o1[bj][q] = dpp_ror1(cur[q]); o2[bj][q] = dpp_ror2(cur[q]); } }
                    u32x2v o;
                    { const float a0 = uu[0][0] * __builtin_amdgcn_rcpf(1.f + __expf(-uu[0][0])) * uu[1][0], a1 = uu[0][1] * __builtin_amdgcn_rcpf(1.f + __expf(-uu[0][1])) * uu[1][1];
                      const float a2 = uu[0][2] * __builtin_amdgcn_rcpf(1.f + __expf(-uu[0][2])) * uu[1][2], a3 = uu[0][3] * __builtin_amdgcn_rcpf(1.f + __expf(-uu[0][3])) * uu[1][3];
                      o.x = cvt_pk_bf16(a0, a1); o.y = cvt_pk_bf16(a2, a3); }
                    *(u32x2v*)(ACT + (size_t)(row0 + ai * HALF + m * 16) * 5632 + u.pn * 128 + cidx + 4 * n) = o;
                }
            }
        }
    }
};
template <class Epi, class Sched, bool ALIGN_EPI = false, bool SP2 = false>
__device__ __forceinline__ void gemm_phase(PG8_LAS unsigned char* lds, const Gemm g, const Sched& S, const Epi& E) {
    int tid_ = threadIdx.x; asm volatile("" : "+v"(tid_));
    const int tid = tid_, wid = __builtin_amdgcn_readfirstlane(tid >> 6), lane = tid & 63, wr = wid >> 2, wc = wid & 3, fr = lane & 15, fq = lane >> 4;
    const int K = g.K, nt = K / BK;
    unsigned voffA[2], voffB[2];
#pragma unroll
    for (int i = 0; i < 2; ++i) { int R, C; stage_rc(tid * 16 + i * 8192, R, C); const int Rb = Epi::PERM ? ((R & ~31) + perm32(R & 31)) : R;
        voffA[i] = (unsigned)(R * K + C) * 2u; voffB[i] = (unsigned)(Rb * K + C) * 2u; }
    const size_t kstep = (size_t)(BK * 2);
    const size_t hstep = (size_t)HALF * K * 2;
    const size_t tstep = 2 * hstep;
    const unsigned ldsw = (unsigned)wid * 1024u;
    const int aoff = lds_byte(wr * 64 + fr, fq * 8), boff = lds_byte(wc * 32 + fr, fq * 8);
#define PG8_SA(b, h) (((b) * 2 + (h)) * HTB)
#define PG8_SB(b, h) ((4 + (b) * 2 + (h)) * HTB)
#define PG8_STAGE(bufoff, gbase, voff) do { _Pragma("unroll") for (int _i = 0; _i < 2; ++_i) \
        __builtin_amdgcn_global_load_lds((const unsigned*)((const char*)(gbase) + (voff)[_i]), (PG8_LAS unsigned*)(lds + (bufoff) + ldsw + _i * 8192), 16, 0, 0); } while (0)
#define PG8_LDA(dst, b, h) do { _Pragma("unroll") for (int m = 0; m < 4; ++m) _Pragma("unroll") for (int k = 0; k < 2; ++k) dst[m][k] = *(const PG8_LAS bf16x8*)(lds + PG8_SA(b, h) + aoff + m * 2048 + k * 1024); } while (0)
#define PG8_LDB(dst, b, h) do { _Pragma("unroll") for (int n = 0; n < 2; ++n) _Pragma("unroll") for (int k = 0; k < 2; ++k) dst[n][k] = *(const PG8_LAS bf16x8*)(lds + PG8_SB(b, h) + boff + n * 2048 + k * 1024); } while (0)
#define PG8_MMA(ai, bj, At, Bt) do { __builtin_amdgcn_s_setprio(1); _Pragma("unroll") for (int m = 0; m < 4; ++m) _Pragma("unroll") for (int n = 0; n < 2; ++n) _Pragma("unroll") for (int k = 0; k < 2; ++k) \
        acc[ai][bj][m][n] = __builtin_amdgcn_mfma_f32_16x16x32_bf16(Bt[n][k], At[m][k], acc[ai][bj][m][n], 0, 0, 0); __builtin_amdgcn_s_setprio(0); } while (0)
#define PG8_WAIT_V(n) asm volatile("s_waitcnt vmcnt(" #n ")" ::: "memory")
#define PG8_WAIT_L(n) asm volatile("s_waitcnt lgkmcnt(" #n ")" ::: "memory")
#define PG8_BAR __builtin_amdgcn_s_barrier()
#define PG8_SCHED __builtin_amdgcn_sched_barrier(0)
    Unit cur, nxt; int ui = 0;
    if (!S.next(0, cur)) return;
    f32x4 acc[2][2][4][2];
#pragma unroll
    for (int a = 0; a < 2; ++a)
#pragma unroll
        for (int b = 0; b < 2; ++b)
#pragma unroll
            for (int m = 0; m < 4; ++m)
#pragma unroll
                for (int n = 0; n < 2; ++n) acc[a][b][m][n] = (f32x4){0.f, 0.f, 0.f, 0.f};
    bf16x8 At[4][2], B0[2][2], B1[2][2];
    const char* cA = (const char*)g.A + (size_t)cur.pm * tstep; const char* cB = (const char*)g.Bt + (size_t)cur.pn * tstep;
    S.a_ready(cur);
    if constexpr (SP2) {
        PG8_STAGE(PG8_SB(0, 0), cB, voffB); PG8_STAGE(PG8_SB(0, 1), cB + hstep, voffB); PG8_STAGE(PG8_SA(0, 0), cA, voffA); PG8_STAGE(PG8_SA(0, 1), cA + hstep, voffA);
        if (wr == 1) PG8_BAR;
        PG8_WAIT_V(2); PG8_BAR;
        PG8_STAGE(PG8_SB(1, 0), cB + kstep, voffB); PG8_STAGE(PG8_SA(1, 0), cA + kstep, voffA); PG8_STAGE(PG8_SB(1, 1), cB + hstep + kstep, voffB);
        PG8_WAIT_V(6); PG8_BAR;
    } else {
        PG8_STAGE(PG8_SB(0, 0), cB, voffB); PG8_STAGE(PG8_SA(0, 0), cA, voffA); PG8_STAGE(PG8_SB(0, 1), cB + hstep, voffB); PG8_STAGE(PG8_SA(0, 1), cA + hstep, voffA);
        if (wr == 1) PG8_BAR;
        PG8_WAIT_V(4); PG8_BAR;
        PG8_STAGE(PG8_SB(1, 0), cB + kstep, voffB); PG8_STAGE(PG8_SA(1, 0), cA + kstep, voffA); PG8_STAGE(PG8_SB(1, 1), cB + hstep + kstep, voffB);
        PG8_WAIT_V(6); PG8_BAR;
    }
    for (;;) {
        const bool has_next = S.next(ui + 1, nxt);
        const char* nA = has_next ? (const char*)g.A + (size_t)nxt.pm * tstep : cA; const char* nB = has_next ? (const char*)g.Bt + (size_t)nxt.pn * tstep : cB;
        for (int t = 0; t < nt; t += 2) {
            const bool last = (t == nt - 2);
            const char* a1 = cA + (size_t)(t + 1) * kstep;
            const char* a2 = last ? nA : cA + (size_t)(t + 2) * kstep; const char* b2 = last ? nB : cB + (size_t)(t + 2) * kstep;
            const char* a3 = a2 + kstep; const char* b3 = b2 + kstep;
            if (last && has_next) S.a_ready(nxt);
            if constexpr (SP2) {
            PG8_LDB(B0, 0, 0); PG8_LDB(B1, 0, 1); PG8_SCHED; PG8_LDA(At, 0, 0); PG8_STAGE(PG8_SA(1, 1), a1 + hstep, voffA);
            PG8_WAIT_V(8); PG8_WAIT_L(0); PG8_BAR; PG8_MMA(0, 0, At, B0); PG8_MMA(0, 1, At, B1); PG8_BAR; PG8_SCHED;
            PG8_LDA(At, 0, 1); PG8_STAGE(PG8_SB(0, 0), b2, voffB); PG8_STAGE(PG8_SB(0, 1), b2 + hstep, voffB); PG8_STAGE(PG8_SA(0, 0), a2, voffA);
            PG8_WAIT_V(8); PG8_WAIT_L(0); PG8_BAR; PG8_MMA(1, 0, At, B0); PG8_MMA(1, 1, At, B1); PG8_BAR; PG8_SCHED;
            PG8_LDB(B0, 1, 0); PG8_LDB(B1, 1, 1); PG8_SCHED; PG8_LDA(At, 1, 0); PG8_STAGE(PG8_SA(0, 1), a2 + hstep, voffA);
            PG8_WAIT_V(8); PG8_WAIT_L(0); PG8_BAR; PG8_MMA(0, 0, At, B0); PG8_MMA(0, 1, At, B1); PG8_BAR; PG8_SCHED;
            PG8_LDA(At, 1, 1); PG8_STAGE(PG8_SB(1, 0), b3, voffB); PG8_STAGE(PG8_SB(1, 1), b3 + hstep, voffB); PG8_STAGE(PG8_SA(1, 0), a3, voffA);
            PG8_WAIT_V(8); PG8_WAIT_L(0); PG8_BAR; PG8_MMA(1, 0, At, B0); PG8_MMA(1, 1, At, B1); PG8_BAR; PG8_SCHED;
            } else {
            PG8_LDB(B0, 0, 0); PG8_SCHED; PG8_LDA(At, 0, 0); PG8_STAGE(PG8_SA(1, 1), a1 + hstep, voffA);
            PG8_WAIT_L(8); PG8_BAR; PG8_WAIT_L(0); PG8_MMA(0, 0, At, B0); PG8_BAR; PG8_SCHED;
            PG8_LDB(B1, 0, 1); PG8_STAGE(PG8_SB(0, 0), b2, voffB);
            PG8_BAR; PG8_WAIT_L(0); PG8_MMA(0, 1, At, B1); PG8_BAR;
            PG8_LDA(At, 0, 1); PG8_STAGE(PG8_SA(0, 0), a2, voffA);
            PG8_BAR; PG8_WAIT_L(0); PG8_MMA(1, 0, At, B0); PG8_BAR; PG8_SCHED;
            PG8_STAGE(PG8_SB(0, 1), b2 + hstep, voffB);
            PG8_WAIT_V(6); PG8_BAR; PG8_MMA(1, 1, At, B1); PG8_BAR;
            PG8_LDB(B0, 1, 0); PG8_SCHED; PG8_LDA(At, 1, 0); PG8_STAGE(PG8_SA(0, 1), a2 + hstep, voffA);
            PG8_WAIT_L(8); PG8_BAR; PG8_WAIT_L(0); PG8_MMA(0, 0, At, B0); PG8_BAR; PG8_SCHED;
            PG8_LDB(B1, 1, 1); PG8_STAGE(PG8_SB(1, 0), b3, voffB);
            PG8_BAR; PG8_WAIT_L(0); PG8_MMA(0, 1, At, B1); PG8_BAR;
            PG8_LDA(At, 1, 1); PG8_STAGE(PG8_SA(1, 0), a3, voffA);
            PG8_BAR; PG8_WAIT_L(0); PG8_MMA(1, 0, At, B0); PG8_BAR; PG8_SCHED;
            PG8_STAGE(PG8_SB(1, 1), b3 + hstep, voffB);
            PG8_WAIT_V(6); PG8_BAR; PG8_MMA(1, 1, At, B1); PG8_BAR;
            }
        }
        if constexpr (ALIGN_EPI) { if (wr == 0) PG8_BAR; }
        if constexpr (!Epi::AFTER_DRAIN) { E(acc, cur, wr, wc, fr, fq); S.done(cur); }
        if (!has_next) break;
#pragma unroll
        for (int a = 0; a < 2; ++a)
#pragma unroll
            for (int b = 0; b < 2; ++b)
#pragma unroll
                for (int m = 0; m < 4; ++m)
#pragma unroll
                    for (int n = 0; n < 2; ++n) acc[a][b][m][n] = (f32x4){0.f, 0.f, 0.f, 0.f};
        cur = nxt; cA = nA; cB = nB; ++ui;
        if constexpr (ALIGN_EPI) { if (wr == 1) PG8_BAR; }
    }
    PG8_WAIT_V(0);
    if constexpr (!ALIGN_EPI) { if (wr == 0) PG8_BAR; }
    PG8_BAR;
    if constexpr (Epi::AFTER_DRAIN) { E.fused(acc, cur, wr, wc, fr, fq, lds, wid, lane); S.done(cur); }
#undef PG8_SA
#undef PG8_SB
#undef PG8_STAGE
#undef PG8_LDA
#undef PG8_LDB
#undef PG8_MMA
#undef PG8_WAIT_V
#undef PG8_WAIT_L
#undef PG8_BAR
#undef PG8_SCHED
}
}

#define DI __device__ __forceinline__
#define LAS __attribute__((address_space(3)))
typedef unsigned short bf16;
typedef float f32x2 __attribute__((ext_vector_type(2)));
typedef float f32x4 __attribute__((ext_vector_type(4)));
typedef float f32x16 __attribute__((ext_vector_type(16)));
typedef short bf16x8 __attribute__((ext_vector_type(8)));
typedef short s16x4 __attribute__((ext_vector_type(4)));
typedef unsigned u32x2 __attribute__((ext_vector_type(2)));
typedef unsigned u32x4 __attribute__((ext_vector_type(4)));
typedef __bf16 bf16x2_t __attribute__((ext_vector_type(2)));

constexpr int NBATCH = 8, SEQ = 2048, T = NBATCH * SEQ, DM = 2048, MIXW = 1536, MEMW = 512, MEML = 256, DFF = 5632;
constexpr int NPH = 32;
constexpr float LOG2E = 1.4426950408889634f;
constexpr int LDS_BYTES = 147456;

constexpr size_t MiB = 1u << 20;
constexpr size_t WS_WIN = 1 * MiB;
constexpr size_t WS_WMKV = 23 * MiB;
constexpr size_t WS_WOUT = 27 * MiB;
constexpr size_t WS_WUP = 35 * MiB;
constexpr size_t WS_WDOWN = 79 * MiB;
constexpr size_t WS_WLORA = 101 * MiB;
constexpr size_t WS_X = 106 * MiB;
constexpr size_t WS_H = 234 * MiB;
constexpr size_t WS_YCAT = 298 * MiB;
constexpr size_t WS_MEMN = 362 * MiB;
constexpr size_t WS_MEMKV = 370 * MiB;
constexpr size_t WS_LORAIN = 378 * MiB;
constexpr size_t WS_P = 394 * MiB;
constexpr size_t WS_LO = 746 * MiB;
constexpr size_t WS_SSPA = 1034 * MiB;
constexpr size_t WS_SSPF = 1036 * MiB;
constexpr size_t WS_WSET1 = 1038 * MiB;
constexpr size_t WS_RAWB = 1144 * MiB;
constexpr size_t WS_MEMN4 = 1156 * MiB;
constexpr size_t WS_END = 1188 * MiB;

DI unsigned pk2(float lo, float hi) { f32x2 v = {lo, hi}; bf16x2_t b = __builtin_convertvector(v, bf16x2_t); return __builtin_bit_cast(unsigned, b); }
DI float bflo(unsigned w) { return __uint_as_float(w << 16); }
DI float bfhi(unsigned w) { return __uint_as_float(w & 0xffff0000u); }
#define LDS_WAIT() asm volatile("s_waitcnt lgkmcnt(0)" ::: "memory")
template <int CTRL> DI float dppf(float x) { return __builtin_bit_cast(float, __builtin_amdgcn_mov_dpp(__builtin_bit_cast(int, x), CTRL, 0xf, 0xf, true)); }
DI float red16(float v) { v += dppf<0xB1>(v); v += dppf<0x4E>(v); v += dppf<0x141>(v); v += dppf<0x128>(v); return v; }
DI float wave_sum(float v) {
#pragma unroll
    for (int o = 1; o < 64; o <<= 1) v += __shfl_xor(v, o);
    return v;
}
DI float dot4(f32x4 a, f32x4 b) { return (a.x * b.x + a.y * b.y) + (a.z * b.z + a.w * b.w); }
DI float frcp(float x) { return __builtin_amdgcn_rcpf(x); }
DI float frsq(float x) { return __builtin_amdgcn_rsqf(x); }
DI float sigmoidf_(float x) { return frcp(1.f + __expf(-x)); }
DI float softplusf_(float x) { return fmaxf(x, 0.f) + __logf(1.f + __expf(-fabsf(x))); }
DI float siluf_(float x) { return x * frcp(1.f + __expf(-x)); }
DI float tanhf_(float x) { return 1.f - 2.f * frcp(__expf(2.f * x) + 1.f); }
DI int crow(int reg, int h) { return (reg & 3) + 8 * (reg >> 2) + 4 * h; }
DI void lds_barrier() { asm volatile("s_waitcnt lgkmcnt(0)" ::: "memory"); __builtin_amdgcn_s_barrier(); asm volatile("" ::: "memory"); }
#define MFMA32(a, b, c) __builtin_amdgcn_mfma_f32_32x32x16_bf16((a), (b), (c), 0, 0, 0)

DI int up_rowmap(int n) { const int hv = n >= 5632 ? 1 : 0, nn = n - hv * 5632; return ((nn >> 7) << 8) + hv * 128 + (nn & 127); }
DI void transpose_item(const float* W, int K, int N, bf16* WT, int item, int nblk, LAS float* scr, int lane, bool up_perm) {
    const int kb = item / nblk, nb = item - kb * nblk, k0 = 64 * kb, n0 = 64 * nb;
    const int c4 = (lane & 15) * 4, kr = lane >> 4;
    const bool inb = (n0 + c4) < N;
    const float* src = W + (size_t)(k0 + kr) * N + n0 + c4;
    f32x4 v[16];
#pragma unroll
    for (int i = 0; i < 16; ++i) v[i] = inb ? *(const f32x4*)(src + (size_t)(4 * i) * N) : (f32x4){0.f, 0.f, 0.f, 0.f};
#pragma unroll
    for (int i = 0; i < 16; ++i) { LAS float* d = scr + (4 * i + kr) * 65 + c4; d[0] = v[i].x; d[1] = v[i].y; d[2] = v[i].z; d[3] = v[i].w; }
    LDS_WAIT(); asm volatile("" ::: "memory");
    const int kc = lane & 7;
#pragma unroll
    for (int j = 0; j < 8; ++j) { const int n = (lane >> 3) + 8 * j; const LAS float* s = scr + (8 * kc) * 65 + n;
        u32x4 o; o.x = pk2(s[0 * 65], s[1 * 65]); o.y = pk2(s[2 * 65], s[3 * 65]); o.z = pk2(s[4 * 65], s[5 * 65]); o.w = pk2(s[6 * 65], s[7 * 65]);
        const int orow = up_perm ? up_rowmap(n0 + n) : n0 + n;
        *(u32x4*)(WT + (size_t)orow * K + k0 + 8 * kc) = o; }
    LDS_WAIT(); asm volatile("" ::: "memory");
}
DI void transpose_weight(const float* W, int K, int N, int Npad, bf16* WT, LAS float* scr, int gw, int NGW, int lane, bool up_perm = false) {
    const int nblk = Npad / 64, nitems = (K / 64) * nblk;
    for (int it = gw; it < nitems; it += NGW) transpose_item(W, K, N, WT, it, nblk, scr, lane, up_perm);
}
DI float lora_w(const float* wd, const float* wa, const float* wg, int n, int k) {
    if (n < 1536) return (k < 96) ? wd[k * 1536 + n] : 0.f;
    if (n < 3072) return (k >= 96 && k < 192) ? wa[(k - 96) * 1536 + (n - 1536)] : 0.f;
    return (k >= 192 && k < 448) ? wg[(k - 192) * 1536 + (n - 3072)] : 0.f;
}

DI void rms_row_bf16(const float* xrow, const float* g, bf16* orow, int lane) {
    const f32x4* xr = (const f32x4*)xrow + lane;
    f32x4 v[8]; float s = 0.f;
#pragma unroll
    for (int j = 0; j < 8; ++j) { v[j] = xr[64 * j]; s += dot4(v[j], v[j]); }
    const float rs = frsq(wave_sum(s) * (1.f / 2048.f) + 1e-6f);
    const f32x4* gr = (const f32x4*)g + lane;
    u32x2* o8 = (u32x2*)orow + lane;
#pragma unroll
    for (int j = 0; j < 8; ++j) { const f32x4 gv = gr[64 * j]; const f32x4 o = v[j] * rs * gv; u32x2 w; w.x = pk2(o.x, o.y); w.y = pk2(o.z, o.w); o8[64 * j] = w; }
}
DI void xg_row(const float* xrow, const float* g, bf16* orow, float* ss_out, int lane) {
    const f32x4* xr = (const f32x4*)xrow + lane;
    const f32x4* gr = (const f32x4*)g + lane;
    u32x2* o8 = (u32x2*)orow + lane;
    float s = 0.f;
#pragma unroll
    for (int j = 0; j < 8; ++j) { const f32x4 v = xr[64 * j]; s += dot4(v, v); const f32x4 o = v * gr[64 * j]; u32x2 w; w.x = pk2(o.x, o.y); w.y = pk2(o.z, o.w); o8[64 * j] = w; }
    s = wave_sum(s);
    if (lane < 32) ss_out[lane] = lane == 0 ? s : 0.f;
}
DI void rms_row_f32(const float* xrow, const float* g, float* orow, int lane) {
    const f32x4* xr = (const f32x4*)xrow + lane;
    f32x4 v[8]; float s = 0.f;
#pragma unroll
    for (int j = 0; j < 8; ++j) { v[j] = xr[64 * j]; s += dot4(v[j], v[j]); }
    const float rs = frsq(wave_sum(s) * (1.f / 2048.f) + 1e-6f);
    const f32x4* gr = (const f32x4*)g + lane;
    f32x4* o = (f32x4*)orow + lane;
#pragma unroll
    for (int j = 0; j < 8; ++j) o[64 * j] = v[j] * rs * gr[64 * j];
}

template <int D> DI void stage_kv(LAS unsigned char* lds, const float* kbase, const float* vbase, long stride, int koff, bool zero_first, int tid) {
    constexpr int KP = D + 8, VP = 264, C4 = D / 4, V_OFF = 256 * KP * 2;
    constexpr int NKT = 256 * C4 / 512, NVT = 128 * C4 / 512;
#pragma unroll 1
    for (int h0 = 0; h0 < NKT; h0 += 4) {
        f32x4 v[4];
#pragma unroll
        for (int i = 0; i < 4; ++i) { const int task = tid + 512 * (h0 + i), key = task / C4, d4 = task - key * C4;
            v[i] = (f32x4){0.f, 0.f, 0.f, 0.f};
            if (!(zero_first && key < 128)) v[i] = *(const f32x4*)(kbase + (long)(koff + key) * stride + 4 * d4); }
#pragma unroll
        for (int i = 0; i < 4; ++i) { const int task = tid + 512 * (h0 + i), key = task / C4, d4 = task - key * C4;
            u32x2 w; w.x = pk2(v[i].x, v[i].y); w.y = pk2(v[i].z, v[i].w);
            *(LAS u32x2*)(lds + (key * KP + 4 * d4) * 2) = w; }
        asm volatile("" ::: "memory");
    }
#pragma unroll 1
    for (int h0 = 0; h0 < NVT; h0 += 2) {
        f32x4 a[2], b[2];
#pragma unroll
        for (int i = 0; i < 2; ++i) { const int task = tid + 512 * (h0 + i), kp = task & 127, d4 = task >> 7;
            a[i] = (f32x4){0.f, 0.f, 0.f, 0.f}; b[i] = a[i];
            if (!(zero_first && kp < 64)) { a[i] = *(const f32x4*)(vbase + (long)(koff + 2 * kp) * stride + 4 * d4); b[i] = *(const f32x4*)(vbase + (long)(koff + 2 * kp + 1) * stride + 4 * d4); } }
#pragma unroll
        for (int i = 0; i < 2; ++i) { const int task = tid + 512 * (h0 + i), kp = task & 127, d4 = task >> 7;
#pragma unroll
            for (int q = 0; q < 4; ++q) *(LAS unsigned*)(lds + V_OFF + ((4 * d4 + q) * VP + 2 * kp) * 2) = pk2(a[i][q], b[i][q]); }
        asm volatile("" ::: "memory");
    }
}
template <int D, bool SWA> DI void attn_unit(LAS unsigned char* lds, const float* qrow, float scale2, float slope2, float sink2, int qpos, bool skip0, bf16* orow, int lane) {
    constexpr int KP = D + 8, VP = 264, NKS = D / 16, NDT = D / 32, V_OFF = 256 * KP * 2;
    const int r32 = lane & 31, h = lane >> 5;
    const int qs = __builtin_amdgcn_readfirstlane(qpos >> 5);
    bf16x8 qf[NKS];
#pragma unroll
    for (int ks = 0; ks < NKS; ++ks) { const f32x4 a = *(const f32x4*)(qrow + ks * 16 + 8 * h) * scale2, b = *(const f32x4*)(qrow + ks * 16 + 8 * h + 4) * scale2;
        u32x4 w; w.x = pk2(a.x, a.y); w.y = pk2(a.z, a.w); w.z = pk2(b.x, b.y); w.w = pk2(b.z, b.w); qf[ks] = __builtin_bit_cast(bf16x8, w); }
    float m = SWA ? sink2 : -1e30f, l = (SWA && h == 0) ? 1.f : 0.f;
    f32x16 O[NDT];
#pragma unroll
    for (int dt = 0; dt < NDT; ++dt)
#pragma unroll
        for (int i = 0; i < 16; ++i) O[dt][i] = 0.f;
#pragma unroll 1
    for (int c = 0; c < 2; ++c) {
        if (SWA && skip0 && c == 0) continue;
        f32x16 S[4];
        float mx = -1e30f;
#pragma unroll
        for (int kt = 0; kt < 4; ++kt) {
            const bool dead = SWA && (c == 0 ? kt < qs : kt > qs), part = SWA && kt == qs;
            if (!dead) {
#pragma unroll
                for (int i = 0; i < 16; ++i) S[kt][i] = 0.f;
#pragma unroll
                for (int ks = 0; ks < NKS; ++ks) { const bf16x8 kf = *(const LAS bf16x8*)(lds + ((c * 128 + kt * 32 + r32) * KP + ks * 16 + 8 * h) * 2); S[kt] = MFMA32(kf, qf[ks], S[kt]); }
#pragma unroll
                for (int i = 0; i < 16; ++i) {
                    if (SWA) { const int j = c * 128 + kt * 32 + crow(i, h); const int dist = qpos + 128 - j;
                        const float sb = S[kt][i] - slope2 * (float)dist;
                        S[kt][i] = (!part || ((dist >= 0) && (dist < 128))) ? sb : -1e30f; }
                    mx = fmaxf(mx, S[kt][i]);
                }
            }
        }
        mx = fmaxf(mx, __shfl_xor(mx, 32));
        const float mn = fmaxf(m, mx), alpha = __builtin_amdgcn_exp2f(m - mn);
        m = mn; l *= alpha;
#pragma unroll
        for (int dt = 0; dt < NDT; ++dt)
#pragma unroll
            for (int i = 0; i < 16; ++i) O[dt][i] *= alpha;
        float ps = 0.f;
#pragma unroll
        for (int kt = 0; kt < 4; ++kt) {
            const bool dead = SWA && (c == 0 ? kt < qs : kt > qs);
            if (!dead) {
#pragma unroll
                for (int i = 0; i < 16; ++i) { const float p = __builtin_amdgcn_exp2f(S[kt][i] - mn); S[kt][i] = p; ps += p; }
#pragma unroll
                for (int s = 0; s < 2; ++s) {
                    u32x4 w; w.x = pk2(S[kt][8 * s + 0], S[kt][8 * s + 1]); w.y = pk2(S[kt][8 * s + 2], S[kt][8 * s + 3]); w.z = pk2(S[kt][8 * s + 4], S[kt][8 * s + 5]); w.w = pk2(S[kt][8 * s + 6], S[kt][8 * s + 7]);
                    const bf16x8 pf = __builtin_bit_cast(bf16x8, w);
#pragma unroll
                    for (int dt = 0; dt < NDT; ++dt) {
                        const LAS unsigned char* ap = lds + V_OFF + ((dt * 32 + r32) * VP + c * 128 + kt * 32 + s * 16 + 4 * h) * 2;
                        const s16x4 lo = *(const LAS s16x4*)ap, hi = *(const LAS s16x4*)(ap + 16);
                        const bf16x8 vf = __builtin_shufflevector(lo, hi, 0, 1, 2, 3, 4, 5, 6, 7);
                        O[dt] = MFMA32(vf, pf, O[dt]);
                    }
                }
            }
        }
        l += ps;
    }
    const float lt = l + __shfl_xor(l, 32), inv = frcp(lt);
#pragma unroll
    for (int dt = 0; dt < NDT; ++dt)
#pragma unroll
        for (int g = 0; g < 4; ++g) { u32x2 w; w.x = pk2(O[dt][4 * g] * inv, O[dt][4 * g + 1] * inv); w.y = pk2(O[dt][4 * g + 2] * inv, O[dt][4 * g + 3] * inv);
            *(u32x2*)(orow + dt * 32 + 8 * g + 4 * h) = w; }
}
DI void swa_item(LAS unsigned char* lds, int it, const float* P, int ld, const float* sinks, bf16* YCAT, int tid, int lane, int wave) {
    const int b = it >> 6, rem = it & 63, blk = rem >> 2, kvh = rem & 3;
    const long tok0 = (long)b * SEQ + blk * 128;
    __syncthreads();
    stage_kv<64>(lds, P + tok0 * ld + 1536 + kvh * 64, P + tok0 * ld + 1792 + kvh * 64, ld, -128, blk == 0, tid);
    __syncthreads();
    for (int u = wave; u < 24; u += 8) {
        const int g = u >> 2, qs = u & 3, hq = kvh * 6 + g, qpos = qs * 32 + (lane & 31);
        const long tq = tok0 + qpos;
        const float slope = exp2f(-8.f * (float)(hq + 1) / 24.f);
        attn_unit<64, true>(lds, P + tq * ld + hq * 64, 0.125f * LOG2E, slope * LOG2E, sinks[hq] * LOG2E, qpos, blk == 0, YCAT + tq * DM + hq * 64, lane);
    }
}
DI void mem_item(LAS unsigned char* lds, int it, const float* P, int ld, int qoff, const float* MEMKV, bf16* YCAT, int tid, int lane, int wave) {
    const int b = it >> 5, rem = it & 31, hh = rem >> 3, qc = rem & 7;
    __syncthreads();
    stage_kv<128>(lds, MEMKV + (long)(b * MEML) * 1024 + hh * 128, MEMKV + (long)(b * MEML) * 1024 + 512 + hh * 128, 1024, 0, false, tid);
    __syncthreads();
    const long tq = (long)b * SEQ + qc * 256 + wave * 32 + (lane & 31);
    attn_unit<128, false>(lds, P + tq * ld + qoff + hh * 128, 0.08838834764831845f * LOG2E, 0.f, 0.f, 0, false, YCAT + tq * DM + MIXW + hh * 128, lane);
}

DI void rwkv_prep_row(const float* P, const float* mu, bf16* LIN, long tg, int lane) {
    u32x4 o = {0u, 0u, 0u, 0u};
    if (lane < 56) {
        const int col = 4608 + 8 * lane;
        const float* cur = P + tg * 5632 + col;
        f32x4 c0 = *(const f32x4*)cur, c1 = *(const f32x4*)(cur + 4), p0 = {0.f, 0.f, 0.f, 0.f}, p1 = {0.f, 0.f, 0.f, 0.f};
        if ((tg & (SEQ - 1)) != 0) { p0 = *(const f32x4*)(cur - 5632); p1 = *(const f32x4*)(cur - 5632 + 4); }
        const f32x4 m0 = *(const f32x4*)(mu + col), m1 = *(const f32x4*)(mu + col + 4);
        f32x4 x0 = c0 + (p0 - c0) * m0, x1 = c1 + (p1 - c1) * m1;
        if (lane < 12) {
#pragma unroll
            for (int i = 0; i < 4; ++i) { x0[i] = tanhf_(x0[i]); x1[i] = tanhf_(x1[i]); }
        } else if (lane >= 24) {
#pragma unroll
            for (int i = 0; i < 4; ++i) { x0[i] = sigmoidf_(x0[i]); x1[i] = sigmoidf_(x1[i]); }
        }
        o.x = pk2(x0.x, x0.y); o.y = pk2(x0.z, x0.w); o.z = pk2(x1.x, x1.y); o.w = pk2(x1.z, x1.w);
    }
    *(u32x4*)(LIN + tg * 512 + 8 * lane) = o;
}

struct RwkvPar { const float *mu, *w0, *a0, *k_k, *k_a, *r_k, *gn_g, *gn_b; };
DI void rwkv_scan_block(LAS unsigned char* lds, int c, const float* P, const float* LO, const RwkvPar& pr, bf16* YCAT, int tid, int lane, int wave) {
    const int b = c / 24, h = c - b * 24;
    const long tok_base = (long)b * SEQ;
    LAS float* R_ = (LAS float*)(lds + 0);
    LAS float* W_ = (LAS float*)(lds + 8192);
    LAS float* K_ = (LAS float*)(lds + 16384);
    LAS float* V_ = (LAS float*)(lds + 24576);
    LAS float* KK_ = (LAS float*)(lds + 32768);
    LAS float* KA_ = (LAS float*)(lds + 40960);
    LAS float* G_ = (LAS float*)(lds + 49152);
    LAS float* Y_ = (LAS float*)(lds + 57344);
    LAS float* BS_ = (LAS float*)(lds + 65536);
    LAS float* RAW = (LAS float*)(lds + 65792);
    const int dt = tid >> 4, k4 = (tid & 15) * 4, ch = h * 64 + k4;
    const int kq = lane & 15, rp = lane >> 4, row0 = wave * 8 + rp * 2;
    f32x4 S0 = {0.f, 0.f, 0.f, 0.f}, S1 = {0.f, 0.f, 0.f, 0.f};
    f32x4 pre[7];
#define RW_LOAD(cidx) do { const int t0_ = (cidx) * 32; _Pragma("unroll") for (int j = 0; j < 7; ++j) { const int e = tid + 512 * j; pre[j] = (f32x4){0.f, 0.f, 0.f, 0.f}; \
        if (e < 3168) { const int row = e / 96, rm = e - row * 96, s = rm >> 4, kk4 = rm & 15; const int t = t0_ - 1 + row; \
            if (t >= 0) { const long tg = tok_base + t; const float* src = (s < 3) ? P + tg * 5632 + s * 1536 + h * 64 + 4 * kk4 : LO + tg * 4608 + (s - 3) * 1536 + h * 64 + 4 * kk4; pre[j] = *(const f32x4*)src; } } } } while (0)
#define RW_WRITE() do { _Pragma("unroll") for (int j = 0; j < 7; ++j) { const int e = tid + 512 * j; if (e < 3168) *(LAS f32x4*)(RAW + 4 * e) = pre[j]; } } while (0)
#define RW_RAW(row, s) (*(const LAS f32x4*)(RAW + ((row) * 6 + (s)) * 64 + k4))
#define RW_DERIVE() do { \
        const f32x4 mu_r = *(const f32x4*)(pr.mu + ch), mu_k = *(const f32x4*)(pr.mu + 1536 + ch), mu_v = *(const f32x4*)(pr.mu + 3072 + ch); \
        const f32x4 cr = RW_RAW(dt + 1, 0), ck = RW_RAW(dt + 1, 1), cv = RW_RAW(dt + 1, 2); \
        const f32x4 xr = cr + (RW_RAW(dt, 0) - cr) * mu_r, xk = ck + (RW_RAW(dt, 1) - ck) * mu_k, xv = cv + (RW_RAW(dt, 2) - cv) * mu_v; \
        const f32x4 wl = *(const f32x4*)(pr.w0 + ch) + RW_RAW(dt + 1, 3), al = *(const f32x4*)(pr.a0 + ch) + RW_RAW(dt + 1, 4); \
        f32x4 dec, av; _Pragma("unroll") for (int i = 0; i < 4; ++i) { const float wlog = -softplusf_(-wl[i]) - 0.5f; dec[i] = __expf(-__expf(wlog)); av[i] = sigmoidf_(al[i]); } \
        const f32x4 kkn = xk * *(const f32x4*)(pr.k_k + ch); const float ss = red16(dot4(kkn, kkn)); const f32x4 kk = kkn * (frsq(ss + 1e-6f)); \
        const f32x4 kp = xk * (1.f + (av - 1.f) * *(const f32x4*)(pr.k_a + ch)); \
        const float bs = red16(dot4(xr * kp, *(const f32x4*)(pr.r_k + ch))); \
        *(LAS f32x4*)(R_ + dt * 64 + k4) = xr; *(LAS f32x4*)(W_ + dt * 64 + k4) = dec; *(LAS f32x4*)(K_ + dt * 64 + k4) = kp; *(LAS f32x4*)(V_ + dt * 64 + k4) = xv; \
        *(LAS f32x4*)(KK_ + dt * 64 + k4) = kk; *(LAS f32x4*)(KA_ + dt * 64 + k4) = kk * av; *(LAS f32x4*)(G_ + dt * 64 + k4) = RW_RAW(dt + 1, 5); \
        if ((tid & 15) == 0) BS_[dt] = bs; } while (0)
    RW_LOAD(0);
#pragma unroll 1
    for (int cidx = 0; cidx < 64; ++cidx) {
        RW_WRITE();
        lds_barrier();
        RW_DERIVE();
        lds_barrier();
        if (cidx + 1 < 64) RW_LOAD(cidx + 1);
        f32x4 nkk = *(const LAS f32x4*)(KK_ + 4 * kq), nw = *(const LAS f32x4*)(W_ + 4 * kq), nka = *(const LAS f32x4*)(KA_ + 4 * kq);
        f32x4 nk = *(const LAS f32x4*)(K_ + 4 * kq), nr = *(const LAS f32x4*)(R_ + 4 * kq);
        f32x2 nv = *(const LAS f32x2*)(V_ + row0);
#pragma unroll 4
        for (int t = 0; t < 32; ++t) {
            const f32x4 kk4 = nkk, w4 = nw, ka4 = nka, kv4 = nk, r4 = nr; const f32x2 v2 = nv;
            const int tn = (t + 1) * 64;
            nkk = *(const LAS f32x4*)(KK_ + tn + 4 * kq); nw = *(const LAS f32x4*)(W_ + tn + 4 * kq); nka = *(const LAS f32x4*)(KA_ + tn + 4 * kq);
            nk = *(const LAS f32x4*)(K_ + tn + 4 * kq); nr = *(const LAS f32x4*)(R_ + tn + 4 * kq); nv = *(const LAS f32x2*)(V_ + tn + row0);
            const float p0 = red16(dot4(S0, kk4)), p1 = red16(dot4(S1, kk4));
            S0 = S0 * w4 - p0 * ka4 + v2.x * kv4;
            S1 = S1 * w4 - p1 * ka4 + v2.y * kv4;
            const float y0 = red16(dot4(S0, r4)), y1 = red16(dot4(S1, r4));
            if (kq == 0) *(LAS f32x2*)(Y_ + t * 64 + row0) = (f32x2){y0, y1};
        }
        lds_barrier();
        {
            const f32x4 y4 = *(const LAS f32x4*)(Y_ + dt * 64 + k4);
            const float mean = red16((y4.x + y4.y) + (y4.z + y4.w)) * (1.f / 64.f);
            const f32x4 d = y4 - mean;
            const float var = red16(dot4(d, d)) * (1.f / 64.f);
            const f32x4 yn = d * (frsq(var + 64e-5f)) * *(const f32x4*)(pr.gn_g + ch) + *(const f32x4*)(pr.gn_b + ch);
            const f32x4 o = (yn + BS_[dt] * *(const LAS f32x4*)(V_ + dt * 64 + k4)) * *(const LAS f32x4*)(G_ + dt * 64 + k4);
            u32x2 w; w.x = pk2(o.x, o.y); w.y = pk2(o.z, o.w);
            *(u32x2*)(YCAT + (tok_base + cidx * 32 + dt) * DM + ch) = w;
        }
    }
#undef RW_LOAD
#undef RW_WRITE
#undef RW_RAW
#undef RW_DERIVE
}

DI f32x4 gd_conv4(const LAS float* CW, const LAS float* RAW, int dt, int cc) {
    f32x4 a = {0.f, 0.f, 0.f, 0.f};
#pragma unroll
    for (int j = 0; j < 4; ++j) a += *(const LAS f32x4*)(CW + j * 320 + cc) * *(const LAS f32x4*)(RAW + (dt + j) * 320 + cc);
#pragma unroll
    for (int i = 0; i < 4; ++i) a[i] = siluf_(a[i]);
    return a;
}
struct GdnPar { const float *conv, *a_log, *dt_bias; };
#define MFMA16F(a, b, c) __builtin_amdgcn_mfma_f32_16x16x4f32((a), (b), (c), 0, 0, 0)
DI void gdn_scan_block(LAS unsigned char* lds, int c, const float* P, const GdnPar& pr, float* ORAW, int tid, int lane, int wave) {
    constexpr int LD = 5376, KP = 132;
    const int b = c / 24, r24 = c - b * 24, vh = r24 >> 1, half = r24 & 1, qh = vh >> 1;
    const long tok_base = (long)b * SEQ;
    LAS float* Q_ = (LAS float*)(lds + 0);
    LAS float* K_ = (LAS float*)(lds + 16896);
    LAS float* V_ = (LAS float*)(lds + 33792);
    LAS float* AB_ = (LAS float*)(lds + 41984);
    LAS float* GC_ = (LAS float*)(lds + 42240);
    LAS float* E31_ = (LAS float*)(lds + 42368);
    LAS float* GM = (LAS float*)(lds + 42496);
    LAS float* HM = (LAS float*)(lds + 46720);
    LAS float* BM = (LAS float*)(lds + 50944);
    LAS float* M2 = (LAS float*)(lds + 55040);
    LAS float* RH = (LAS float*)(lds + 59264);
    LAS float* CC = (LAS float*)(lds + 67456);
    LAS float* CW = (LAS float*)(lds + 75648);
    LAS float* RAW = (LAS float*)(lds + 80768);
    LAS float* RAB = (LAS float*)(lds + 125568);
    LAS unsigned char* KB = lds + 125824;
    LAS unsigned char* QB = lds + 134528;
    const int dt = tid >> 4, seg = tid & 15;
    const int m = lane & 15, g = lane >> 4;
#define GD_COL(cc) ((cc) < 128 ? qh * 128 + (cc) : (cc) < 256 ? 768 + qh * 128 + ((cc) - 128) : 1536 + vh * 128 + half * 64 + ((cc) - 256))
    for (int e = tid; e < 4 * 320; e += 512) { const int j = e / 320, cc = e - j * 320; CW[e] = pr.conv[j * 3072 + GD_COL(cc)]; }
    const float neg_ea = -__expf(pr.a_log[vh]), dtb = pr.dt_bias[vh];
    f32x4 Sacc[8];
#pragma unroll
    for (int i = 0; i < 8; ++i) Sacc[i] = (f32x4){0.f, 0.f, 0.f, 0.f};
    f32x4 pre[6]; float pre_bt = 0.f, pre_at = 0.f;
#define GD_LOAD(cidx) do { const int t0_ = (cidx) * 32; _Pragma("unroll") for (int j = 0; j < 6; ++j) { const int e = tid + 512 * j; pre[j] = (f32x4){0.f, 0.f, 0.f, 0.f}; \
        if (e < 2800) { const int row = e / 80, c4 = e - row * 80; const int t = t0_ - 3 + row; \
            if (t >= 0) { const int cc = 4 * c4; pre[j] = *(const f32x4*)(P + (tok_base + t) * LD + GD_COL(cc)); } } } \
        if (tid < 32) { const float* pp = P + (tok_base + t0_ + tid) * LD; pre_bt = pp[4608 + vh]; pre_at = pp[4620 + vh]; } } while (0)
#define GD_WRITE() do { _Pragma("unroll") for (int j = 0; j < 6; ++j) { const int e = tid + 512 * j; if (e < 2800) *(LAS f32x4*)(RAW + 4 * e) = pre[j]; } \
        if (tid < 32) { RAB[2 * tid] = pre_bt; RAB[2 * tid + 1] = pre_at; } } while (0)
#define GD_CONV4(cc) gd_conv4(CW, RAW, dt, (cc))
#define GD_DERIVE() do { \
        f32x4 q0 = GD_CONV4(seg * 8), q1 = GD_CONV4(seg * 8 + 4), k0 = GD_CONV4(128 + seg * 8), k1 = GD_CONV4(128 + seg * 8 + 4); const f32x4 v0 = GD_CONV4(256 + seg * 4); \
        const float qs = 0.08838834764831845f * frsq(red16(dot4(q0, q0) + dot4(q1, q1)) + 1e-6f), ks = frsq(red16(dot4(k0, k0) + dot4(k1, k1)) + 1e-6f); \
        *(LAS f32x4*)(Q_ + dt * KP + seg * 8) = q0 * qs; *(LAS f32x4*)(Q_ + dt * KP + seg * 8 + 4) = q1 * qs; \
        *(LAS f32x4*)(K_ + dt * KP + seg * 8) = k0 * ks; *(LAS f32x4*)(K_ + dt * KP + seg * 8 + 4) = k1 * ks; \
        *(LAS f32x4*)(V_ + dt * 64 + seg * 4) = v0; \
        { const f32x4 a0_ = q0 * qs, a1_ = q1 * qs, b0_ = k0 * ks, b1_ = k1 * ks; u32x4 wq, wk; \
          wq.x = pk2(a0_.x, a0_.y); wq.y = pk2(a0_.z, a0_.w); wq.z = pk2(a1_.x, a1_.y); wq.w = pk2(a1_.z, a1_.w); \
          wk.x = pk2(b0_.x, b0_.y); wk.y = pk2(b0_.z, b0_.w); wk.z = pk2(b1_.x, b1_.y); wk.w = pk2(b1_.z, b1_.w); \
          *(LAS u32x4*)(QB + (dt * 136 + seg * 8) * 2) = wq; *(LAS u32x4*)(KB + (dt * 136 + seg * 8) * 2) = wk; } \
        if (seg == 0) { AB_[2 * dt] = neg_ea * softplusf_(RAB[2 * dt + 1] + dtb); AB_[2 * dt + 1] = sigmoidf_(RAB[2 * dt]); } } while (0)
    GD_LOAD(0);
#pragma unroll 1
    for (int cidx = 0; cidx < 64; ++cidx) {
        GD_WRITE();
        lds_barrier();
        GD_DERIVE();
        lds_barrier();
        if (cidx + 1 < 64) GD_LOAD(cidx + 1);
        f32x4 P0a[2], PQa[2];
        if (wave < 4) {
#pragma unroll
            for (int tb = 0; tb < 2; ++tb) { P0a[tb] = (f32x4){0.f, 0.f, 0.f, 0.f}; PQa[tb] = P0a[tb]; }
#pragma unroll
            for (int kb8 = 0; kb8 < 8; ++kb8)
#pragma unroll
                for (int i = 0; i < 4; ++i) { const float bS = Sacc[kb8][i];
#pragma unroll
                    for (int tb = 0; tb < 2; ++tb) { const int off = (16 * tb + m) * KP + 16 * kb8 + 4 * g + i;
                        P0a[tb] = MFMA16F(K_[off], bS, P0a[tb]); } }
#pragma unroll
            for (int ks = 0; ks < 4; ++ks) {
                u32x4 w; w.x = pk2(Sacc[2 * ks][0], Sacc[2 * ks][1]); w.y = pk2(Sacc[2 * ks][2], Sacc[2 * ks][3]); w.z = pk2(Sacc[2 * ks + 1][0], Sacc[2 * ks + 1][1]); w.w = pk2(Sacc[2 * ks + 1][2], Sacc[2 * ks + 1][3]);
                const bf16x8 bSb = __builtin_bit_cast(bf16x8, w);
#pragma unroll
                for (int tb = 0; tb < 2; ++tb) { const LAS unsigned char* qp = QB + ((16 * tb + m) * 136 + 32 * ks + 4 * g) * 2;
                    const s16x4 lo = *(const LAS s16x4*)qp, hi = *(const LAS s16x4*)(qp + 32);
                    PQa[tb] = __builtin_amdgcn_mfma_f32_16x16x32_bf16(__builtin_shufflevector(lo, hi, 0, 1, 2, 3, 4, 5, 6, 7), bSb, PQa[tb], 0, 0, 0); } }
        } else {
            const int gw4 = wave - 4, tb = gw4 & 1; const LAS unsigned char* XB = (gw4 >> 1) ? QB : KB; LAS float* OUT = (gw4 >> 1) ? HM : GM;
            f32x4 acc[2] = {(f32x4){0.f, 0.f, 0.f, 0.f}, (f32x4){0.f, 0.f, 0.f, 0.f}};
#pragma unroll
            for (int ks = 0; ks < 4; ++ks) { const bf16x8 aX = *(const LAS bf16x8*)(XB + ((16 * tb + m) * 136 + 32 * ks + 8 * g) * 2);
#pragma unroll
                for (int jb = 0; jb < 2; ++jb) acc[jb] = __builtin_amdgcn_mfma_f32_16x16x32_bf16(aX, *(const LAS bf16x8*)(KB + ((16 * jb + m) * 136 + 32 * ks + 8 * g) * 2), acc[jb], 0, 0, 0); }
#pragma unroll
            for (int jb = 0; jb < 2; ++jb)
#pragma unroll
                for (int i = 0; i < 4; ++i) OUT[(16 * tb + 4 * g + i) * 33 + 16 * jb + m] = acc[jb][i];
            if (wave == 4 && lane == 0) { float s = 0.f;
                for (int t = 0; t < 32; ++t) { s += AB_[2 * t]; GC_[t] = s; }
                for (int t = 0; t < 32; ++t) E31_[t] = __expf(s - GC_[t]); }
        }
        lds_barrier();
#pragma unroll
        for (int rep = 0; rep < 2; ++rep) { const int e = tid + 512 * rep, t = e >> 5, j = e & 31;
            const float d = __expf(GC_[t] - GC_[j]);
            BM[t * 32 + j] = (j < t) ? AB_[2 * t + 1] * d * GM[t * 33 + j] : 0.f;
            M2[t * 33 + j] = (j <= t) ? d * HM[t * 33 + j] : 0.f; }
        lds_barrier();
        if (wave < 4) {
            const int cw16 = 16 * wave;
#pragma unroll
            for (int tb = 0; tb < 2; ++tb)
#pragma unroll
                for (int i = 0; i < 4; ++i) { const int t = 16 * tb + 4 * g + i;
                    RH[t * 64 + cw16 + m] = AB_[2 * t + 1] * (V_[t * 64 + cw16 + m] - __expf(GC_[t]) * P0a[tb][i]); }
            LDS_WAIT(); asm volatile("" ::: "memory");
            if (lane < 16) {
                float cc[32];
                const int rowi = cw16 + lane;
#pragma unroll
                for (int tb8 = 0; tb8 < 4; ++tb8) {
                    float acc[8];
#pragma unroll
                    for (int r = 0; r < 8; ++r) acc[r] = RH[(8 * tb8 + r) * 64 + rowi];
#pragma unroll
                    for (int jb = 0; jb < tb8; ++jb)
#pragma unroll
                        for (int r = 0; r < 8; ++r) { const f32x4 b0 = *(const LAS f32x4*)(BM + (8 * tb8 + r) * 32 + 8 * jb), b1 = *(const LAS f32x4*)(BM + (8 * tb8 + r) * 32 + 8 * jb + 4);
                            acc[r] -= ((b0[0] * cc[8 * jb] + b0[1] * cc[8 * jb + 1]) + (b0[2] * cc[8 * jb + 2] + b0[3] * cc[8 * jb + 3])) + ((b1[0] * cc[8 * jb + 4] + b1[1] * cc[8 * jb + 5]) + (b1[2] * cc[8 * jb + 6] + b1[3] * cc[8 * jb + 7])); }
#pragma unroll
                    for (int rh = 0; rh < 2; ++rh) {
                        f32x4 d0[4], d1[4];
#pragma unroll
                        for (int r = 0; r < 4; ++r) { d0[r] = *(const LAS f32x4*)(BM + (8 * tb8 + 4 * rh + r) * 32 + 8 * tb8); if (rh) d1[r] = *(const LAS f32x4*)(BM + (8 * tb8 + 4 * rh + r) * 32 + 8 * tb8 + 4); }
#pragma unroll
                        for (int r = 0; r < 4; ++r) { float av = acc[4 * rh + r];
#pragma unroll
                            for (int q = 0; q < 8; ++q) if (q < 4 * rh + r) av -= (q < 4 ? d0[r][q & 3] : d1[r][q & 3]) * cc[8 * tb8 + q];
                            cc[8 * tb8 + 4 * rh + r] = av; CC[(8 * tb8 + 4 * rh + r) * 64 + rowi] = av; }
                    }
                }
            }
            LDS_WAIT(); asm volatile("" ::: "memory");
            float bC[8];
#pragma unroll
            for (int js = 0; js < 8; ++js) bC[js] = CC[(4 * js + g) * 64 + cw16 + m];
#pragma unroll
            for (int tb = 0; tb < 2; ++tb) { f32x4 o;
#pragma unroll
                for (int i = 0; i < 4; ++i) o[i] = PQa[tb][i] * __expf(GC_[16 * tb + 4 * g + i]);
#pragma unroll
                for (int js = 0; js < 8; ++js) o = MFMA16F(M2[(16 * tb + m) * 33 + 4 * js + g], bC[js], o);
#pragma unroll
                for (int i = 0; i < 4; ++i) ORAW[(tok_base + cidx * 32 + 16 * tb + 4 * g + i) * MIXW + vh * 128 + half * 64 + cw16 + m] = o[i]; }
            const float e31 = __expf(GC_[31]);
            float ej[8];
#pragma unroll
            for (int js = 0; js < 8; ++js) ej[js] = E31_[4 * js + g];
#pragma unroll
            for (int kb8 = 0; kb8 < 8; ++kb8) { f32x4 acc = Sacc[kb8] * e31;
#pragma unroll
                for (int js = 0; js < 8; ++js) acc = MFMA16F(K_[(4 * js + g) * KP + 16 * kb8 + m] * ej[js], bC[js], acc);
                Sacc[kb8] = acc; }
        }
        lds_barrier();
    }
#undef GD_COL
#undef GD_LOAD
#undef GD_WRITE
#undef GD_CONV4
#undef GD_DERIVE
}
DI void gdn_post_row(const float* ORAW, const float* P, const float* norm_g, bf16* YCAT, long tg, int lane) {
    const f32x2 g2 = *(const f32x2*)(norm_g + 2 * lane);
#pragma unroll 4
    for (int vh = 0; vh < 12; ++vh) {
        const f32x2 o = *(const f32x2*)(ORAW + tg * MIXW + vh * 128 + 2 * lane);
        const f32x2 z = *(const f32x2*)(P + tg * 5376 + 3072 + vh * 128 + 2 * lane);
        const float rs = frsq(wave_sum(o.x * o.x + o.y * o.y) * (1.f / 128.f) + 1e-6f);
        *(unsigned*)(YCAT + tg * DM + vh * 128 + 2 * lane) = pk2(o.x * rs * g2.x * siluf_(z.x), o.y * rs * g2.y * siluf_(z.y));
    }
}

DI void ffn_conv_task(const bf16* UP, const float* cw, bf16* ACT, int task) {
    const int cg8 = task % 704, strip = task / 704, c = cg8 * 8;
    const long t0 = (long)strip * 32;
    f32x4 wg[3][2], wv[3][2];
#pragma unroll
    for (int j = 0; j < 3; ++j) { wg[j][0] = *(const f32x4*)(cw + j * 11264 + c); wg[j][1] = *(const f32x4*)(cw + j * 11264 + c + 4);
        wv[j][0] = *(const f32x4*)(cw + j * 11264 + 5632 + c); wv[j][1] = *(const f32x4*)(cw + j * 11264 + 5632 + c + 4); }
    u32x4 g2 = {0u, 0u, 0u, 0u}, g1 = g2, v2 = g2, v1 = g2;
    if ((t0 & (SEQ - 1)) != 0) {
        g2 = *(const u32x4*)(UP + (t0 - 2) * 11264 + c); v2 = *(const u32x4*)(UP + (t0 - 2) * 11264 + 5632 + c);
        g1 = *(const u32x4*)(UP + (t0 - 1) * 11264 + c); v1 = *(const u32x4*)(UP + (t0 - 1) * 11264 + 5632 + c);
    }
#pragma unroll 4
    for (int i = 0; i < 32; ++i) {
        const long t = t0 + i;
        const u32x4 g0 = *(const u32x4*)(UP + t * 11264 + c), v0 = *(const u32x4*)(UP + t * 11264 + 5632 + c);
        u32x4 o;
#pragma unroll
        for (int q = 0; q < 4; ++q) {
            const int hf = q >> 1, e0 = (q & 1) * 2;
            const float ug0 = wg[0][hf][e0] * bflo(g2[q]) + wg[1][hf][e0] * bflo(g1[q]) + wg[2][hf][e0] * bflo(g0[q]);
            const float ug1 = wg[0][hf][e0 + 1] * bfhi(g2[q]) + wg[1][hf][e0 + 1] * bfhi(g1[q]) + wg[2][hf][e0 + 1] * bfhi(g0[q]);
            const float uv0 = wv[0][hf][e0] * bflo(v2[q]) + wv[1][hf][e0] * bflo(v1[q]) + wv[2][hf][e0] * bflo(v0[q]);
            const float uv1 = wv[0][hf][e0 + 1] * bfhi(v2[q]) + wv[1][hf][e0 + 1] * bfhi(v1[q]) + wv[2][hf][e0 + 1] * bfhi(v0[q]);
            o[q] = pk2(siluf_(ug0) * uv0, siluf_(ug1) * uv1);
        }
        *(u32x4*)(ACT + t * DFF + c) = o;
        g2 = g1; g1 = g0; v2 = v1; v1 = v0;
    }
}

#define XB_TMO      128
#define XB_XCNT(j)  (256  + 64 * (j))
#define XB_XSUB(j)  (1280 + 64 * (j))
#define XB_XGEN(j)  (2304 + 64 * (j))
#define XB_TOP      3328
#define XB_TOPGEN   3392
#define XCD_BAR_WORDS 3456
#define XB_SPIN_CAP (1u << 18)

__device__ __forceinline__ unsigned xb_ld(unsigned* p)              { return __hip_atomic_load(p, __ATOMIC_RELAXED, __HIP_MEMORY_SCOPE_AGENT); }
__device__ __forceinline__ unsigned xb_add(unsigned* p, unsigned v) { return __hip_atomic_fetch_add(p, v, __ATOMIC_RELAXED, __HIP_MEMORY_SCOPE_AGENT); }
__device__ __forceinline__ bool xb_tid0() { int t_ = threadIdx.x; asm volatile("" : "+v"(t_)); return t_ == 0; }
__device__ __forceinline__ unsigned xb_xcc_id() { return (unsigned)__builtin_amdgcn_s_getreg((3 << 11) | 20) & 0xFu; }
#define XB_SPIN(cond, bar) do { unsigned _sp = 0; while (cond) { __builtin_amdgcn_s_sleep(1); \
    if ((++_sp & 255u) == 0u) { if (xb_ld(&(bar)[XB_TMO])) break; if (_sp > XB_SPIN_CAP) { atomicAdd(&(bar)[XB_TMO], 1u); break; } } } } while (0)

struct XcdBarrier {
    unsigned* bar; unsigned x;
    volatile LAS unsigned* st;
};

__device__ __forceinline__ XcdBarrier xcd_barrier_post(unsigned* bar, volatile LAS unsigned* st) {
    XcdBarrier b; b.bar = bar; b.x = xb_xcc_id(); b.st = st;
    if (xb_tid0()) (void)xb_add(&bar[XB_XCNT(b.x)], 1u);
    return b;
}
__device__ __forceinline__ void xcd_barrier_complete(unsigned* bar, unsigned x, unsigned& nloc, unsigned& nx) {
    const unsigned G = gridDim.x * gridDim.y * gridDim.z;
    unsigned sum, cnt, mine, sp = 0u;
    for (;;) {
        sum = 0u; cnt = 0u; mine = 0u;
#pragma unroll
        for (unsigned j = 0; j < 16; ++j) { const unsigned c = xb_ld(&bar[XB_XCNT(j)]); sum += c; cnt += (c > 0u) ? 1u : 0u; mine = (j == x) ? c : mine; }
        if (sum == G) break;
        __builtin_amdgcn_s_sleep(1);
        if ((++sp & 255u) == 0u) { if (xb_ld(&bar[XB_TMO])) break; if (sp > XB_SPIN_CAP) { atomicAdd(&bar[XB_TMO], 1u); break; } }
    }
    nloc = mine > 0u ? mine : 1u; nx = cnt > 0u ? cnt : 1u;
}

__device__ __forceinline__ void xcd_barrier(const XcdBarrier& b) {
    asm volatile("s_waitcnt vmcnt(0)" ::: "memory");
    __syncthreads();
    if (xb_tid0()) {
        unsigned* bar = b.bar;
        __builtin_amdgcn_s_waitcnt(0);
        unsigned nloc = b.st[0], nx = b.st[1];
        if (nloc == 0u) { xcd_barrier_complete(bar, b.x, nloc, nx); b.st[0] = nloc; b.st[1] = nx; }
        const unsigned old = xb_add(&bar[XB_XSUB(b.x)], 1u);
        const unsigned gen = old / nloc;
        if (old + 1u == (gen + 1u) * nloc) {
            __builtin_amdgcn_fence(__ATOMIC_RELEASE, "agent");
            asm volatile("s_waitcnt vmcnt(0)" ::: "memory");
            const unsigned og = xb_add(&bar[XB_TOP], 1u);
            const unsigned tg = og / nx;
            if (og + 1u == (tg + 1u) * nx) xb_add(&bar[XB_TOPGEN], 1u);
            else XB_SPIN(xb_ld(&bar[XB_TOPGEN]) == tg, bar);
            __builtin_amdgcn_fence(__ATOMIC_ACQUIRE, "agent");
            xb_add(&bar[XB_XGEN(b.x)], 1u);
            asm volatile("s_waitcnt vmcnt(0)" ::: "memory");
        } else {
            XB_SPIN(xb_ld(&bar[XB_XGEN(b.x)]) == gen, bar);
            __builtin_amdgcn_fence(__ATOMIC_ACQUIRE, "agent");
            asm volatile("s_waitcnt vmcnt(0)" ::: "memory");
        }
    }
    __syncthreads();
}

constexpr int LDS_BAR_ST = LDS_BYTES - 64;

struct Args { const float* in[30]; float* out; unsigned char* ws; int lo, hi; };
typedef const __attribute__((address_space(4))) Args* KArgs;
struct Ctx {
    KArgs ap; unsigned char* ws; LAS unsigned char* lds;
    int tid, lane, wave, G, bid, gw, NGW;
    bf16 *WT_IN, *WT_MKV, *WT_OUT, *WT_UP, *WT_DOWN, *WT_LORA, *H, *YCAT, *MEMN, *LORAIN, *UP, *ACT;
    float *X, *MEMKV, *P, *LO, *ORAW, *SSA, *SSF;
};
DI Ctx make_ctx(LAS unsigned char* lds, int layer) {
    Ctx c;
    KArgs ap = (KArgs)__builtin_amdgcn_kernarg_segment_ptr(); asm volatile("" : "+s"(ap));
    int tid = threadIdx.x; asm volatile("" : "+v"(tid));
    int bid = blockIdx.x; asm volatile("" : "+s"(bid));
    c.ap = ap; { unsigned l_ = (unsigned)(uintptr_t)lds; asm volatile("" : "+s"(l_)); c.lds = (LAS unsigned char*)(uintptr_t)l_; } c.tid = tid; c.lane = tid & 63; c.wave = __builtin_amdgcn_readfirstlane(tid >> 6); int G_ = gridDim.x; asm volatile("" : "+s"(G_)); c.G = G_; c.bid = bid; c.gw = bid * 8 + c.wave; c.NGW = c.G * 8;
    unsigned char* ws = ap->ws; c.ws = ws;
    { unsigned char* wsw = ws + ((layer & 1) ? WS_WSET1 : 0);
    c.WT_IN = (bf16*)(wsw + WS_WIN); c.WT_MKV = (bf16*)(wsw + WS_WMKV); c.WT_OUT = (bf16*)(wsw + WS_WOUT); c.WT_UP = (bf16*)(wsw + WS_WUP); c.WT_DOWN = (bf16*)(wsw + WS_WDOWN); c.WT_LORA = (bf16*)(wsw + WS_WLORA); }
    c.X = (float*)(ws + WS_X); c.H = (bf16*)(ws + WS_H); c.YCAT = (bf16*)(ws + WS_YCAT); c.MEMN = (bf16*)(ws + WS_MEMN4 + (size_t)layer * 8 * MiB); c.MEMKV = (float*)(ws + WS_MEMKV);
    c.LORAIN = (bf16*)(ws + WS_LORAIN); c.P = (float*)(ws + WS_P); c.LO = (float*)(ws + WS_LO); c.UP = (bf16*)(ws + WS_P); c.ACT = (bf16*)(ws + WS_LO); c.ORAW = (float*)(ws + WS_LO); c.SSA = (float*)(ws + WS_SSPA); c.SSF = (float*)(ws + WS_SSPF);
    return c;
}
#define INP(k) ((const float*)c.ap->in[k])
DI int nin_of(int kind) { return kind == 0 ? 2560 : kind == 1 ? 5568 : 5144; }
DI int npad_of(int kind) { return kind == 0 ? 2560 : kind == 1 ? 5632 : 5376; }
DI int qoff_of(int kind) { return kind == 0 ? 2048 : kind == 1 ? 5056 : 4632; }

DI void convert_layer_weights(const Ctx& c, int layer, int gw, int NGW, int which) {
    const int kind = layer % 3, jj = layer / 3;
    unsigned char* wsw = c.ws + ((layer & 1) ? WS_WSET1 : 0);
    const float* w_in = kind == 0 ? INP(11) + (size_t)jj * 2048 * 2560 : kind == 1 ? INP(13) : INP(25);
    LAS float* scr = (LAS float*)(c.lds + c.wave * 16640);
    if (which & 1) transpose_weight(w_in, 2048, nin_of(kind), npad_of(kind), (bf16*)(wsw + WS_WIN), scr, gw, NGW, c.lane);
    if (which & 2) transpose_weight(INP(4) + (size_t)layer * 2048 * 1024, 2048, 1024, 1024, (bf16*)(wsw + WS_WMKV), scr, gw, NGW, c.lane);
    if (which & 4) transpose_weight(INP(5) + (size_t)layer * 2048 * 2048, 2048, 2048, 2048, (bf16*)(wsw + WS_WOUT), scr, gw, NGW, c.lane);
    if (which & 8) transpose_weight(INP(7) + (size_t)layer * 2048 * 11264, 2048, 11264, 11264, (bf16*)(wsw + WS_WUP), scr, gw, NGW, c.lane, true);
    if (which & 16) transpose_weight(INP(9) + (size_t)layer * 5632 * 2048, 5632, 2048, 2048, (bf16*)(wsw + WS_WDOWN), scr, gw, NGW, c.lane);
    if (kind == 1 && (which & 32)) {
        const float *wd = INP(16), *wa = INP(18), *wg = INP(19); bf16* WL = (bf16*)(wsw + WS_WLORA);
        for (int idx = gw * 64 + c.lane; idx < 4608 * 64; idx += NGW * 64) { const int n = idx >> 6, k0 = (idx & 63) * 8;
            u32x4 o; o.x = pk2(lora_w(wd, wa, wg, n, k0), lora_w(wd, wa, wg, n, k0 + 1)); o.y = pk2(lora_w(wd, wa, wg, n, k0 + 2), lora_w(wd, wa, wg, n, k0 + 3));
            o.z = pk2(lora_w(wd, wa, wg, n, k0 + 4), lora_w(wd, wa, wg, n, k0 + 5)); o.w = pk2(lora_w(wd, wa, wg, n, k0 + 6), lora_w(wd, wa, wg, n, k0 + 7));
            *(u32x4*)(WL + (size_t)n * 512 + k0) = o; }
    }
}
DI void phase_prep(const Ctx& c) {
    convert_layer_weights(c, 0, c.gw, c.NGW, 0x3f);
    convert_layer_weights(c, 1, c.gw, c.NGW, 0x23);
    { const float* gn = INP(2); const float* x0 = INP(0);
      for (int m = c.gw; m < T; m += c.NGW) xg_row(x0 + (size_t)m * DM, gn, c.H + (size_t)m * DM, c.SSA + (size_t)m * 32, c.lane); }
    const float* mem = INP(1);
    for (int m = c.gw; m < 4 * NBATCH * MEML; m += c.NGW) { const int l = m / (NBATCH * MEML), r = m - l * (NBATCH * MEML);
        rms_row_bf16(mem + (size_t)r * DM, INP(3) + l * DM, (bf16*)(c.ws + WS_MEMN4 + (size_t)l * 8 * MiB) + (size_t)r * DM, c.lane); }
}
DI void phase_inproj(const Ctx& c, int layer) {
    const int Npad = npad_of(layer % 3);
    { pg8::Gemm g{c.H, c.WT_IN, T, Npad, 2048}; pg8::StaticOrder S; S.init(T, Npad, c.G, c.bid); pg8::EpiF32 E{c.P, Npad, c.SSA};
      pg8::gemm_phase<pg8::EpiF32, pg8::StaticOrder, true, true>(c.lds, g, S, E); }
    { const int rem = ((T / 256) * (Npad / 256)) % c.G; const int c2 = (c.bid - rem + c.G) % c.G;
      pg8::Gemm g{c.MEMN, c.WT_MKV, NBATCH * MEML, 1024, 2048}; pg8::StaticOrder S; S.init(NBATCH * MEML, 1024, c.G, c2); pg8::EpiF32 E{c.MEMKV, 1024, nullptr};
      pg8::gemm_phase<pg8::EpiF32, pg8::StaticOrder, true, true>(c.lds, g, S, E); }
}
DI void phase_swa(const Ctx& c, int layer) {
    const float* sinks = INP(12) + (layer / 3) * 24;
    for (int it = c.bid; it < 512; it += c.G) swa_item(c.lds, it, c.P, 2560, sinks, c.YCAT, c.tid, c.lane, c.wave);
    for (int it = c.bid; it < 256; it += c.G) mem_item(c.lds, it, c.P, 2560, 2048, c.MEMKV, c.YCAT, c.tid, c.lane, c.wave);
}
DI void phase_rwkv_prep(const Ctx& c) {
    const float* mu = INP(14);
    for (long m = c.gw; m < T; m += c.NGW) rwkv_prep_row(c.P, mu, c.LORAIN, m, c.lane);
}
DI void phase_rwkv_lora(const Ctx& c) {
    pg8::Gemm g{c.LORAIN, c.WT_LORA, T, 4608, 512}; pg8::StaticOrder S; S.init(T, 4608, c.G, c.bid); pg8::EpiF32 E{c.LO, 4608, nullptr};
    pg8::gemm_phase<pg8::EpiF32, pg8::StaticOrder, true, true>(c.lds, g, S, E);
}
DI void phase_rwkv_scan(const Ctx& c) {
    if (c.bid < 192) { const RwkvPar pr{INP(14), INP(15), INP(17), INP(20), INP(21), INP(22), INP(23), INP(24)}; rwkv_scan_block(c.lds, c.bid, c.P, c.LO, pr, c.YCAT, c.tid, c.lane, c.wave); }
    else { for (int it = c.bid - 192; it < 256; it += c.G - 192) mem_item(c.lds, it, c.P, 5632, 5056, c.MEMKV, c.YCAT, c.tid, c.lane, c.wave);
        __syncthreads(); convert_layer_weights(c, 1, (c.bid - 192) * 8 + c.wave, (c.G - 192) * 8, 0x1c); convert_layer_weights(c, 2, (c.bid - 192) * 8 + c.wave, (c.G - 192) * 8, 0x03); }
}
DI void phase_gdn_scan(const Ctx& c) {
    if (c.bid < 192) { const GdnPar pr{INP(26), INP(27), INP(28)}; gdn_scan_block(c.lds, c.bid, c.P, pr, c.ORAW, c.tid, c.lane, c.wave); }
    else { for (int it = c.bid - 192; it < 256; it += c.G - 192) mem_item(c.lds, it, c.P, 5376, 4632, c.MEMKV, c.YCAT, c.tid, c.lane, c.wave);
        __syncthreads(); convert_layer_weights(c, 2, (c.bid - 192) * 8 + c.wave, (c.G - 192) * 8, 0x1c); convert_layer_weights(c, 3, (c.bid - 192) * 8 + c.wave, (c.G - 192) * 8, 0x3f); }
}
DI void phase_gdn_post(const Ctx& c) {
    const float* ng = INP(29);
    for (long m = c.gw; m < T; m += c.NGW) gdn_post_row(c.ORAW, c.P, ng, c.YCAT, m, c.lane);
}
DI void phase_outproj(const Ctx& c, int layer) {
    const float* xsrc = layer == 0 ? INP(0) : c.X;
    pg8::Gemm g{c.YCAT, c.WT_OUT, T, 2048, 2048}; pg8::StaticOrder S; S.init(T, 2048, c.G, c.bid); pg8::EpiResNorm E{xsrc, c.X, 2048, INP(6) + layer * DM, c.H, c.SSF};
    pg8::gemm_phase<pg8::EpiResNorm, pg8::StaticOrder, true, true>(c.lds, g, S, E);
}
DI void phase_ffn_up(const Ctx& c, int layer) {
    pg8::Gemm g{c.H, c.WT_UP, T, 11264, 2048}; pg8::StaticOrder S; S.init(T, 11264, c.G, c.bid);
    pg8::EpiUpConv E{c.ACT, c.SSF, INP(8) + (size_t)layer * 3 * 11264, (float*)(c.ws + WS_RAWB), c.lds + 131072};
    pg8::gemm_phase<pg8::EpiUpConv, pg8::StaticOrder, true, true>(c.lds, g, S, E);
}
DI void ffn_fix_tile(const Ctx& c, const float* cw, int pm) {
    if ((pm & 7) == 0) return;
    const float* RAWB = (const float*)(c.ws + WS_RAWB);
    for (int idx = c.tid; idx < 2 * 1408; idx += 512) {
        const int r = idx / 1408, c4 = idx - r * 1408, col = 4 * c4;
        const float* cur_t = RAWB + ((size_t)pm * 4 + r) * 11264;
        const float* p1_t = r == 0 ? RAWB + ((size_t)(pm - 1) * 4 + 3) * 11264 : RAWB + ((size_t)pm * 4 + 0) * 11264;
        const float* p2_t = r == 0 ? RAWB + ((size_t)(pm - 1) * 4 + 2) * 11264 : RAWB + ((size_t)(pm - 1) * 4 + 3) * 11264;
        f32x4 ug = *(const f32x4*)(cw + col) * *(const f32x4*)(p2_t + col) + *(const f32x4*)(cw + 11264 + col) * *(const f32x4*)(p1_t + col) + *(const f32x4*)(cw + 2 * 11264 + col) * *(const f32x4*)(cur_t + col);
        f32x4 uv = *(const f32x4*)(cw + 5632 + col) * *(const f32x4*)(p2_t + 5632 + col) + *(const f32x4*)(cw + 11264 + 5632 + col) * *(const f32x4*)(p1_t + 5632 + col) + *(const f32x4*)(cw + 2 * 11264 + 5632 + col) * *(const f32x4*)(cur_t + 5632 + col);
        u32x2 o; o.x = pk2(siluf_(ug.x) * uv.x, siluf_(ug.y) * uv.y); o.y = pk2(siluf_(ug.z) * uv.z, siluf_(ug.w) * uv.w);
        *(u32x2*)(c.ACT + ((size_t)pm * 256 + r) * DFF + col) = o;
    }
}
DI void phase_ffn_down(const Ctx& c, int layer) {
    const float* gnext = layer < 3 ? INP(2) + (layer + 1) * DM : INP(10);
    pg8::Gemm g{c.ACT, c.WT_DOWN, T, 2048, 5632}; pg8::StaticOrder S; S.init(T, 2048, c.G, c.bid);
    {
        const float* cw = INP(8) + (size_t)layer * 3 * 11264; pg8::Unit u; int last_pm = -1;
        for (int i = 0; S.next(i, u); ++i) if (u.pm != last_pm) { ffn_fix_tile(c, cw, u.pm); last_pm = u.pm; }
        asm volatile("s_waitcnt vmcnt(0)" ::: "memory"); __syncthreads();
    } pg8::EpiResNorm E{c.X, layer < 3 ? c.X : nullptr, 2048, gnext, c.H, c.SSA};
    pg8::gemm_phase<pg8::EpiResNorm, pg8::StaticOrder, true, true>(c.lds, g, S, E);
}
DI void phase_final(const Ctx& c) {
    float* out = c.ap->out;
    for (int m = c.gw; m < T; m += c.NGW) {
        const float part = c.lane < 32 ? c.SSA[(size_t)m * 32 + c.lane] : 0.f;
        const float rs = frsq(wave_sum(part) * (1.f / 2048.f) + 1e-6f);
        const u32x4* xg = (const u32x4*)(c.H + (size_t)m * DM) + c.lane;
        f32x4* o = (f32x4*)(out + (size_t)m * DM) + 2 * c.lane;
#pragma unroll
        for (int j = 0; j < 4; ++j) { const u32x4 w = xg[64 * j];
            o[128 * j] = (f32x4){bflo(w.x) * rs, bfhi(w.x) * rs, bflo(w.y) * rs, bfhi(w.y) * rs};
            o[128 * j + 1] = (f32x4){bflo(w.z) * rs, bfhi(w.z) * rs, bflo(w.w) * rs, bfhi(w.w) * rs}; }
    }
}

__global__ void __launch_bounds__(512, 2) mega_fwd(Args args) {
    extern __shared__ __attribute__((aligned(16))) unsigned char lds_raw[];
    LAS unsigned char* lds = (LAS unsigned char*)lds_raw;
    cg::grid_group grid = cg::this_grid();
    const int lo = args.lo, hi = args.hi;
    int ph = 0;
    if (hi - lo > 1) {
        volatile LAS unsigned* st = (volatile LAS unsigned*)(lds + LDS_BAR_ST);
        if (threadIdx.x == 0) { st[0] = 0u; st[1] = 0u; }
        __syncthreads();
        (void)xcd_barrier_post((unsigned*)args.ws, st);
    }
#define PHASE(call) do { if (ph >= lo && ph < hi) { { const Ctx c = make_ctx(lds, layer); call; } if (ph + 1 < hi) { if (ph == 0) grid.sync(); else { XcdBarrier xb_; xb_.bar = (unsigned*)make_ctx(lds, 0).ws; xb_.x = xb_xcc_id(); xb_.st = (volatile LAS unsigned*)(make_ctx(lds, 0).lds + LDS_BAR_ST); xcd_barrier(xb_); } } } ++ph; } while (0)
#pragma unroll 1
    for (int layer = 0; layer < 4; ++layer) {
        const int kind = layer % 3;
        if (layer == 0) PHASE(phase_prep(c));
        PHASE(phase_inproj(c, layer));
        if (kind == 0) {
            PHASE(phase_swa(c, layer));
        } else if (kind == 1) {
            PHASE(phase_rwkv_prep(c));
            PHASE(phase_rwkv_lora(c));
            PHASE(phase_rwkv_scan(c));
        } else {
            PHASE(phase_gdn_scan(c));
            PHASE(phase_gdn_post(c));
        }
        PHASE(phase_outproj(c, layer));
        PHASE(phase_ffn_up(c, layer));
        PHASE(phase_ffn_down(c, layer));
    }
    { const int layer = 0; PHASE(phase_final(c)); }
#undef PHASE
}

#ifndef MK_COOP
#define MK_COOP 1
#endif
extern "C" void kernel_launch(void* const* d_in, const int* in_sizes, int n_in, void* d_out, int out_size, void* d_ws, size_t ws_size, hipStream_t stream) {
    static int grid = 0;
    if (grid == 0) {
        if (n_in != 30 || out_size != T * DM || ws_size < WS_END) { fprintf(stderr, "kernel_launch: unexpected problem (n_in %d out %d ws %zu)\n", n_in, out_size, ws_size); grid = -1; return; }
        int dev = 0, cus = 0, per_cu = 0;
        hipGetDevice(&dev); hipDeviceGetAttribute(&cus, hipDeviceAttributeMultiprocessorCount, dev);
        if (hipFuncSetAttribute((const void*)mega_fwd, hipFuncAttributeMaxDynamicSharedMemorySize, LDS_BYTES) != hipSuccess) { fprintf(stderr, "kernel_launch: hipFuncSetAttribute failed\n"); grid = -1; return; }
        hipOccupancyMaxActiveBlocksPerMultiprocessor(&per_cu, (const void*)mega_fwd, 512, LDS_BYTES);
        (void)hipGetLastError();
        if (per_cu < 1) { fprintf(stderr, "kernel_launch: occupancy query says %d blocks per CU\n", per_cu); per_cu = 1; }
        grid = cus * 1;
        if (grid <= 192) { fprintf(stderr, "kernel_launch: this kernel needs more than 192 CUs (got %d)\n", grid); grid = -1; return; }
        fprintf(stderr, "kernel_launch: grid %d (cus %d, per_cu %d)\n", grid, cus, per_cu);
    }
    if (grid < 0) return;
    Args a{};
    for (int i = 0; i < 30; ++i) a.in[i] = (const float*)d_in[i];
    a.out = (float*)d_out; a.ws = (unsigned char*)d_ws;
#if MK_COOP
    if (hipMemsetAsync(d_ws, 0, XCD_BAR_WORDS * 4, stream) != hipSuccess) { fprintf(stderr, "kernel_launch: hipMemsetAsync of the barrier words failed\n"); return; }
    a.lo = 0; a.hi = 1 << 20;
    void* kargs[] = {&a};
    hipError_t e = hipLaunchCooperativeKernel((const void*)mega_fwd, dim3(grid), dim3(512), kargs, LDS_BYTES, stream);
    if (e != hipSuccess) fprintf(stderr, "kernel_launch: cooperative launch failed: %s (grid %d)\n", hipGetErrorString(e), grid);
#else
    for (int p = 0; p < NPH; ++p) { a.lo = p; a.hi = p + 1; hipLaunchKernelGGL(mega_fwd, dim3(grid), dim3(512), LDS_BYTES, stream, a); }
#endif
}
```
